# Optimizing an MI355X kernel written in HIP

```python
import math
import numpy as np
import jax, jax.numpy as jnp
from jax import lax

D_MODEL = 1024
BATCH = 32
SEQ = 2048
DEPTH = 2
DEC_BATCH = 2
DEC_SEQ = 8192
PAST_LEN = 128

GRID_W = 64
NA_HEADS = 8
NA_HEAD_DIM = 64
NA_WIDTH = NA_HEADS * NA_HEAD_DIM
NA_WIN_ROWS_MAX = 8
NA_WIN_COLS = 16
CONV_CH = 512
CONV_WIDTH = 31
DIFF_HEADS = 4
DIFF_HEAD_DIM = 64
DIFF_WIDTH = DIFF_HEADS * 2 * DIFF_HEAD_DIM
N_BRANCH = 3
BRANCH_W = 512
T5_BUCKETS = 32
T5_MAX_DIST = 128
Q_BLOCK = 128
FFN_HIDDEN = -(-8 * D_MODEL // (3 * 256)) * 256
EPS = 1e-6

NA_COLS = 3 * NA_WIDTH
CONV_COLS = 2 * CONV_CH
DIFF_COLS = 3 * DIFF_WIDTH
GATE_COLS = N_BRANCH * D_MODEL
OFF_CONV = NA_COLS
OFF_DIFF = OFF_CONV + CONV_COLS
OFF_GATE = OFF_DIFF + DIFF_COLS
IN_COLS = OFF_GATE + GATE_COLS

kernel_name = "hybrid_natten_conformer_diffattn_encoder"


def rms_norm(x, g):
    xf = x.astype(jnp.float32)
    y = xf * lax.rsqrt(jnp.mean(xf * xf, axis=-1, keepdims=True) + EPS)
    return (y * g.astype(jnp.float32)).astype(x.dtype)


def layer_norm(x, g, b):
    xf = x.astype(jnp.float32)
    mu = jnp.mean(xf, axis=-1, keepdims=True)
    xc = xf - mu
    y = xc * lax.rsqrt(jnp.mean(xc * xc, axis=-1, keepdims=True) + EPS)
    return (y * g.astype(jnp.float32) + b.astype(jnp.float32)).astype(x.dtype)


def t5_bucket(rel):
    nb = T5_BUCKETS // 2
    max_exact = nb // 2
    ret = jnp.where(rel > 0, nb, 0)
    n = jnp.abs(rel)
    nf = jnp.maximum(n, 1).astype(jnp.float32)
    large = max_exact + (jnp.log(nf / max_exact) / math.log(T5_MAX_DIST / max_exact)
                         * (nb - max_exact)).astype(jnp.int32)
    large = jnp.minimum(large, nb - 1)
    return ret + jnp.where(n < max_exact, n, large)


def neighbourhood_attention(q, k, v, rpb):
    B, S, H, dh = q.shape
    rows = S // GRID_W
    kr = min(NA_WIN_ROWS_MAX, rows)
    kw = NA_WIN_COLS
    qg = q.reshape(B, rows, GRID_W, H, dh)
    kg = k.reshape(B, rows, GRID_W, H, dh)
    vg = v.reshape(B, rows, GRID_W, H, dh)
    col = np.arange(GRID_W)
    col_start = np.clip(col - kw // 2, 0, GRID_W - kw)
    col_idx = col_start[:, None] + np.arange(kw)[None, :]
    col_off = col_idx - col[:, None] + (NA_WIN_COLS - 1)
    col_bias = rpb[:, :, col_off]
    scale = dh ** -0.5

    def one_row(args):
        r, q_row = args
        rs = jnp.clip(r - kr // 2, 0, rows - kr)
        kb = lax.dynamic_slice_in_dim(kg, rs, kr, axis=1)[:, :, col_idx]
        vb = lax.dynamic_slice_in_dim(vg, rs, kr, axis=1)[:, :, col_idx]
        row_off = rs + jnp.arange(kr) - r + (NA_WIN_ROWS_MAX - 1)
        bias = jnp.take(col_bias, row_off, axis=1).transpose(0, 2, 1, 3)
        s = (jnp.einsum('bwhd,bawkhd->bhwak', q_row, kb).astype(jnp.float32) * scale
             + bias[None].astype(jnp.float32))
        p = jax.nn.softmax(s.reshape(B, H, GRID_W, kr * kw), axis=-1)
        p = p.reshape(s.shape).astype(v.dtype)
        return jnp.einsum('bhwak,bawkhd->bwhd', p, vb)

    out = lax.map(one_row, (jnp.arange(rows), qg.transpose(1, 0, 2, 3, 4)))
    return out.transpose(1, 0, 2, 3, 4).reshape(B, S, H * dh)


def conformer_conv(u, dw_w, dw_b, ln_g, ln_b):
    a, g = jnp.split(u, 2, axis=-1)
    x = a * jax.nn.sigmoid(g)
    x = lax.conv_general_dilated(
        x, dw_w[:, None, :], window_strides=(1,),
        padding=[(CONV_WIDTH // 2, CONV_WIDTH // 2)],
        dimension_numbers=('NWC', 'WIO', 'NWC'),
        feature_group_count=CONV_CH) + dw_b
    x = layer_norm(x, ln_g, ln_b)
    return jax.nn.silu(x)


def diff_attention(q, k, v, t5_table, lam, subln_g, lam_init):
    B, S, H, _, dh = q.shape
    lf = lam.astype(jnp.float32)
    lam_full = jnp.exp(jnp.sum(lf[0] * lf[1])) - jnp.exp(jnp.sum(lf[2] * lf[3])) + lam_init
    nblk = S // Q_BLOCK
    qb = q.reshape(B, nblk, Q_BLOCK, H, 2, dh).transpose(1, 0, 2, 3, 4, 5)
    kpos = jnp.arange(S)
    scale = dh ** -0.5

    def one_block(args):
        i, q_blk = args
        qpos = i * Q_BLOCK + jnp.arange(Q_BLOCK)
        bias = t5_table[t5_bucket(kpos[None, :] - qpos[:, None])]
        bias = bias.transpose(2, 0, 1).astype(jnp.float32)
        s = jnp.einsum('bqhcd,bkhcd->cbhqk', q_blk, k).astype(jnp.float32) * scale + bias
        p = jax.nn.softmax(s, axis=-1)
        a = (p[0] - lam_full * p[1]).astype(v.dtype)
        return jnp.einsum('bhqk,bkhe->bqhe', a, v)

    o = lax.map(one_block, (jnp.arange(nblk), qb))
    o = o.transpose(1, 0, 2, 3, 4).reshape(B, S, H, 2 * dh)
    o = rms_norm(o, subln_g) * (1.0 - lam_init)
    return o.reshape(B, S, H * 2 * dh)


def trunk(x, w_in, b_gate, na_rpb, conv_dw_w, conv_dw_b, conv_ln_g, conv_ln_b,
          diff_lambda, diff_subln_g, t5_bias, w_branch, w_out,
          ln_mix_pre, ln_mix_post, ln_ffn_pre, ln_ffn_post, w_ffn_in, w_ffn_out):
    B, S, _ = x.shape
    for l in range(DEPTH):
        lam_init = 0.8 - 0.6 * math.exp(-0.3 * l)
        h = rms_norm(x, ln_mix_pre[l])
        u = h @ w_in[l]
        na_q, na_k, na_v = jnp.split(u[..., :NA_COLS].reshape(B, S, 3, NA_HEADS, NA_HEAD_DIM), 3, axis=2)
        o_na = neighbourhood_attention(na_q[:, :, 0], na_k[:, :, 0], na_v[:, :, 0], na_rpb[l])
        o_cv = conformer_conv(u[..., OFF_CONV:OFF_DIFF], conv_dw_w[l], conv_dw_b[l], conv_ln_g[l], conv_ln_b[l])
        du = u[..., OFF_DIFF:OFF_GATE]
        d_q = du[..., :DIFF_WIDTH].reshape(B, S, DIFF_HEADS, 2, DIFF_HEAD_DIM)
        d_k = du[..., DIFF_WIDTH:2 * DIFF_WIDTH].reshape(B, S, DIFF_HEADS, 2, DIFF_HEAD_DIM)
        d_v = du[..., 2 * DIFF_WIDTH:].reshape(B, S, DIFF_HEADS, 2 * DIFF_HEAD_DIM)
        o_df = diff_attention(d_q, d_k, d_v, t5_bias, diff_lambda[l], diff_subln_g[l], lam_init)
        gates = jax.nn.sigmoid((u[..., OFF_GATE:] + b_gate[l]).reshape(B, S, N_BRANCH, D_MODEL))
        br = jnp.stack([o_na, o_cv, o_df], axis=2)
        proj = jnp.einsum('bsnc,ncd->bsnd', br, w_branch[l])
        merged = jnp.sum(gates * proj, axis=2)
        x = x + rms_norm(merged @ w_out[l], ln_mix_post[l])
        hf = rms_norm(x, ln_ffn_pre[l])
        gu = hf @ w_ffn_in[l]
        g, up = jnp.split(gu, 2, axis=-1)
        x = x + rms_norm((jax.nn.silu(g) * up) @ w_ffn_out[l], ln_ffn_post[l])
    return x


def setup_inputs(seed: int = 0) -> dict:
    key = jax.random.key(seed)
    ks = jax.random.split(key, 20)
    nrm = lambda k, shape, s: jax.random.normal(k, shape, jnp.float32) * s
    gain = lambda k, shape: 1.0 + 0.05 * jax.random.normal(k, shape, jnp.float32)
    return {
        "x_prompt": nrm(ks[0], (BATCH, SEQ, D_MODEL), 1.0),
        "x_sample": nrm(ks[1], (DEC_BATCH, DEC_SEQ, D_MODEL), 1.0),
        "w_in": nrm(ks[2], (DEPTH, D_MODEL, IN_COLS), D_MODEL ** -0.5),
        "b_gate": nrm(ks[3], (DEPTH, GATE_COLS), 0.1),
        "na_rpb": nrm(ks[4], (DEPTH, NA_HEADS, 2 * NA_WIN_ROWS_MAX - 1, 2 * NA_WIN_COLS - 1), 0.2),
        "conv_dw_w": nrm(ks[5], (DEPTH, CONV_WIDTH, CONV_CH), CONV_WIDTH ** -0.5),
        "conv_dw_b": nrm(ks[6], (DEPTH, CONV_CH), 0.02),
        "conv_ln_g": gain(ks[7], (DEPTH, CONV_CH)),
        "conv_ln_b": nrm(ks[8], (DEPTH, CONV_CH), 0.02),
        "diff_lambda": nrm(ks[9], (DEPTH, 4, DIFF_HEAD_DIM), 0.1),
        "diff_subln_g": gain(ks[10], (DEPTH, 2 * DIFF_HEAD_DIM)),
        "t5_bias": nrm(ks[11], (T5_BUCKETS, DIFF_HEADS), 0.2),
        "w_branch": nrm(ks[12], (DEPTH, N_BRANCH, BRANCH_W, D_MODEL), BRANCH_W ** -0.5),
        "w_out": nrm(ks[13], (DEPTH, D_MODEL, D_MODEL), D_MODEL ** -0.5),
        "ln_mix_pre": gain(ks[14], (DEPTH, D_MODEL)),
        "ln_mix_post": gain(ks[15], (DEPTH, D_MODEL)),
        "ln_ffn_pre": gain(ks[16], (DEPTH, D_MODEL)),
        "ln_ffn_post": gain(ks[17], (DEPTH, D_MODEL)),
        "w_ffn_in": nrm(ks[18], (DEPTH, D_MODEL, 2 * FFN_HIDDEN), D_MODEL ** -0.5),
        "w_ffn_out": nrm(ks[19], (DEPTH, FFN_HIDDEN, D_MODEL), FFN_HIDDEN ** -0.5),
    }


def reference(x_prompt, x_sample, w_in, b_gate, na_rpb, conv_dw_w, conv_dw_b, conv_ln_g, conv_ln_b,
              diff_lambda, diff_subln_g, t5_bias, w_branch, w_out,
              ln_mix_pre, ln_mix_post, ln_ffn_pre, ln_ffn_post, w_ffn_in, w_ffn_out):
    y_prompt = trunk(x_prompt, w_in, b_gate, na_rpb, conv_dw_w, conv_dw_b, conv_ln_g, conv_ln_b,
                     diff_lambda, diff_subln_g, t5_bias, w_branch, w_out,
                     ln_mix_pre, ln_mix_post, ln_ffn_pre, ln_ffn_post, w_ffn_in, w_ffn_out)
    y_sample = trunk(x_sample, w_in, b_gate, na_rpb, conv_dw_w, conv_dw_b, conv_ln_g, conv_ln_b,
                     diff_lambda, diff_subln_g, t5_bias, w_branch, w_out,
                     ln_mix_pre, ln_mix_post, ln_ffn_pre, ln_ffn_post, w_ffn_in, w_ffn_out)
    return (y_prompt, y_sample)
```

```cpp
#include <hip/hip_runtime.h>
#include <hip/hip_cooperative_groups.h>
#include <cstdio>
#include <cstdint>
namespace cg = cooperative_groups;

#ifdef PROBE_GEMM
#define PREP for (int rep9 = 0; rep9 < 2; ++rep9)
#else
#define PREP
#endif
#ifndef MK_SPLIT
#define MK_SPLIT 0
#endif

#define LAS __attribute__((address_space(3)))
typedef unsigned short bf16_t;
typedef short bf16x8 __attribute__((ext_vector_type(8)));
typedef short s16x4 __attribute__((ext_vector_type(4)));
typedef float f32x4 __attribute__((ext_vector_type(4)));
typedef float f32x2 __attribute__((ext_vector_type(2)));
typedef float f32x16 __attribute__((ext_vector_type(16)));
typedef unsigned u32x4 __attribute__((ext_vector_type(4)));
typedef unsigned u32x2 __attribute__((ext_vector_type(2)));
typedef __bf16 bf16x2_t __attribute__((ext_vector_type(2)));

constexpr int T_TOK = 81920, NP_TOK = 65536, DM = 1024;
constexpr int SEQ_P = 2048, SEQ_S = 8192;
constexpr int IN_COLS = 7168, MIXC = 4096, GATEC = 3072, FFH = 2816, FF2 = 5632;
constexpr int DEPTH = 2;
constexpr float EPS = 1e-6f;
constexpr float LOG2E = 1.4426950408889634f;
constexpr float QSCALE = 0.125f * LOG2E;

constexpr size_t MiB = 1u << 20;
constexpr size_t SEC_ELEMS = (size_t)T_TOK * 512;
constexpr size_t SEC_BYTES = SEC_ELEMS * 2;
enum { S_NAQ = 0, S_NAK = 1, S_NAV = 2, S_CA = 3, S_CG = 4, S_DQ = 5, S_DK = 6, S_DV = 7 };
constexpr size_t WS_U = 0;
constexpr size_t WS_OCV = 8 * SEC_BYTES;
constexpr size_t WS_XB = 9 * SEC_BYTES;
constexpr size_t WS_W = 11 * SEC_BYTES;
constexpr size_t W_MIX = 0, W_GATE = W_MIX + (size_t)MIXC * DM, W_BR = W_GATE + (size_t)GATEC * DM, W_OUT = W_BR + (size_t)3 * DM * 512,
                 W_F1 = W_OUT + (size_t)DM * DM, W_F2 = W_F1 + (size_t)FF2 * DM, W_LAYER = W_F2 + (size_t)DM * FFH;
constexpr size_t WS_SMALL = WS_W + ((2 * W_LAYER * 2 + MiB - 1) / MiB) * MiB;
constexpr size_t RS_BYTES = (size_t)T_TOK * 4;
constexpr size_t WS_RSA = WS_SMALL, WS_RSB = WS_RSA + RS_BYTES, WS_SS = WS_RSB + RS_BYTES;
constexpr size_t WS_BAR = WS_SS + 4 * 32 * RS_BYTES;
constexpr size_t BAR_BYTES = 16384;
constexpr size_t WS_END = WS_BAR + BAR_BYTES;
constexpr size_t WS_MERGED = 1 * SEC_BYTES;
constexpr size_t WS_Y1 = 3 * SEC_BYTES;
constexpr size_t WS_GSCR = 6 * SEC_BYTES;
constexpr size_t WS_HID = 0;
constexpr size_t WS_Y2 = 6 * SEC_BYTES;
static_assert((size_t)T_TOK * FFH * 2 <= 6 * SEC_BYTES, "hidden overlay");

constexpr int LDS_BYTES = 147456;
constexpr int LDS_TAB = 131072;

__device__ __forceinline__ unsigned cvtpk(float lo, float hi) { f32x2 v = {lo, hi}; bf16x2_t b = __builtin_convertvector(v, bf16x2_t); return __builtin_bit_cast(unsigned, b); }
__device__ __forceinline__ float bflo(unsigned u) { return __uint_as_float(u << 16); }
__device__ __forceinline__ float bfhi(unsigned u) { return __uint_as_float(u & 0xffff0000u); }
__device__ __forceinline__ float wave_sum(float v) {
#pragma unroll
    for (int o = 1; o < 64; o <<= 1) v += __shfl_xor(v, o);
    return v;
}
__device__ __forceinline__ float sigmoidf_(float x) { return __builtin_amdgcn_rcpf(1.f + __expf(-x)); }

namespace gm {
constexpr int TM = 256, TN = 128, BK = 64, A_STAGE = TM * BK * 2, B_STAGE = TN * BK * 2, STAGE = A_STAGE + B_STAGE;
__device__ __forceinline__ unsigned sw(unsigned r, unsigned c) { return r * 128u + ((c ^ ((r >> 1) & 7u)) << 4); }
typedef f32x4 Acc[4][4];
template <class Epi>
__device__ __forceinline__ void gemm_unit(LAS unsigned char* lds, const bf16_t* __restrict__ A, const bf16_t* __restrict__ Bt, int K, const Epi& E, int pm, int pn) {
    int tid = threadIdx.x; asm volatile("" : "+v"(tid));
    const int lane = tid & 63, wid = __builtin_amdgcn_readfirstlane(tid >> 6), wm = wid >> 1, wn = wid & 1, fr = lane & 15, fq = lane >> 4;
    const int r0 = tid >> 3, c0 = tid & 7;
    const bf16_t* ga = A + (size_t)(pm * TM + r0) * K + c0 * 8;
    const bf16_t* gb = Bt + (size_t)(pn * TN + r0) * K + c0 * 8;
    const size_t rstep = (size_t)64 * K;
    const unsigned lw = sw(r0, c0);
    const unsigned ra = sw(wm * 64 + fr, fq), rb = sw(wn * 64 + fr, fq);
    Acc acc;
#pragma unroll
    for (int m = 0; m < 4; ++m)
#pragma unroll
        for (int n = 0; n < 4; ++n) acc[m][n] = (f32x4){0.f, 0.f, 0.f, 0.f};
    u32x4 pa[4], pb[2];
#pragma unroll
    for (int i = 0; i < 4; ++i) pa[i] = *(const u32x4*)(ga + i * rstep);
#pragma unroll
    for (int i = 0; i < 2; ++i) pb[i] = *(const u32x4*)(gb + i * rstep);
#pragma unroll
    for (int i = 0; i < 4; ++i) *(LAS u32x4*)(lds + lw + i * 8192) = pa[i];
#pragma unroll
    for (int i = 0; i < 2; ++i) *(LAS u32x4*)(lds + A_STAGE + lw + i * 8192) = pb[i];
    __syncthreads();
    const int nk = K / BK;
    for (int kt = 0; kt < nk; ++kt) {
        const LAS unsigned char* Ab = lds + (kt & 1) * STAGE; const LAS unsigned char* Bb = Ab + A_STAGE;
        if (kt + 1 < nk) {
#pragma unroll
            for (int i = 0; i < 4; ++i) pa[i] = *(const u32x4*)(ga + (size_t)(kt + 1) * BK + i * rstep);
#pragma unroll
            for (int i = 0; i < 2; ++i) pb[i] = *(const u32x4*)(gb + (size_t)(kt + 1) * BK + i * rstep);
        }
#pragma unroll
        for (int kk = 0; kk < 2; ++kk) {
            bf16x8 af[4], bfr[4];
#pragma unroll
            for (int m = 0; m < 4; ++m) af[m] = *(const LAS bf16x8*)(Ab + ((ra + m * 2048) ^ (kk * 64)));
#pragma unroll
            for (int n = 0; n < 4; ++n) bfr[n] = *(const LAS bf16x8*)(Bb + ((rb + n * 2048) ^ (kk * 64)));
#pragma unroll
            for (int m = 0; m < 4; ++m)
#pragma unroll
                for (int n = 0; n < 4; ++n) acc[m][n] = __builtin_amdgcn_mfma_f32_16x16x32_bf16(bfr[n], af[m], acc[m][n], 0, 0, 0);
        }
        if (kt + 1 < nk) { LAS unsigned char* nb = lds + ((kt + 1) & 1) * STAGE;
#pragma unroll
            for (int i = 0; i < 4; ++i) *(LAS u32x4*)(nb + lw + i * 8192) = pa[i];
#pragma unroll
            for (int i = 0; i < 2; ++i) *(LAS u32x4*)(nb + A_STAGE + lw + i * 8192) = pb[i];
        }
        __syncthreads();
    }
    E(acc, pm * TM + wm * 64, pn * TN + wn * 64, fr, fq);
}

__device__ __forceinline__ u32x2 pack4(f32x4 v) { u32x2 w; w.x = cvtpk(v[0], v[1]); w.y = cvtpk(v[2], v[3]); return w; }
__device__ __forceinline__ f32x4 unpack4(u32x2 w) { return (f32x4){bflo(w.x), bfhi(w.x), bflo(w.y), bfhi(w.y)}; }

struct EpiMix {
    bf16_t* U; const float* rs;
    __device__ __forceinline__ void operator()(const Acc& acc, int row0, int col0, int fr, int fq) const {
        const int sec = col0 >> 9; bf16_t* base = U + (size_t)sec * SEC_ELEMS + (col0 & 511) + 4 * fq; const float sc = (sec == S_NAQ || sec == S_DQ) ? QSCALE : 1.f;
#pragma unroll
        for (int m = 0; m < 4; ++m) { const int row = row0 + m * 16 + fr; const float r = rs[row] * sc; bf16_t* rowp = base + (size_t)row * 512;
#pragma unroll
            for (int n = 0; n < 4; ++n) *(u32x2*)(rowp + n * 16) = pack4(acc[m][n] * r); }
    }
};
struct EpiGate {
    u32x2* gscr; const float* rs; const float* bias;
    __device__ __forceinline__ void operator()(const Acc& acc, int row0, int col0, int fr, int fq) const {
        u32x2* slot = gscr + threadIdx.x;
        f32x4 bv[4];
#pragma unroll
        for (int n = 0; n < 4; ++n) bv[n] = *(const f32x4*)(bias + col0 + n * 16 + 4 * fq);
#pragma unroll
        for (int m = 0; m < 4; ++m) { const float r = rs[row0 + m * 16 + fr];
#pragma unroll
            for (int n = 0; n < 4; ++n) { f32x4 v = acc[m][n] * r + bv[n];
#pragma unroll
                for (int j = 0; j < 4; ++j) v[j] = sigmoidf_(v[j]);
                slot[(m * 4 + n) * 512] = pack4(v); } }
    }
};
struct EpiProj {
    const u32x2* gscr; bf16_t* merged; int first;
    __device__ __forceinline__ void operator()(const Acc& acc, int row0, int col0, int fr, int fq) const {
        const u32x2* slot = gscr + threadIdx.x;
#pragma unroll
        for (int m = 0; m < 4; ++m) { bf16_t* rowp = merged + (size_t)(row0 + m * 16 + fr) * DM + col0 + 4 * fq;
#pragma unroll
            for (int n = 0; n < 4; ++n) { f32x4 v = unpack4(slot[(m * 4 + n) * 512]) * acc[m][n];
                if (!first) v += unpack4(*(const u32x2*)(rowp + n * 16));
                *(u32x2*)(rowp + n * 16) = pack4(v); } }
    }
};
struct EpiY {
    bf16_t* Y; float* ss;
    __device__ __forceinline__ void operator()(const Acc& acc, int row0, int col0, int fr, int fq) const {
#pragma unroll
        for (int m = 0; m < 4; ++m) { const int row = row0 + m * 16 + fr; bf16_t* rowp = Y + (size_t)row * DM + col0 + 4 * fq; float s = 0.f;
#pragma unroll
            for (int n = 0; n < 4; ++n) { const f32x4 v = acc[m][n]; s += (v[0] * v[0] + v[1] * v[1]) + (v[2] * v[2] + v[3] * v[3]); *(u32x2*)(rowp + n * 16) = pack4(v); }
            s += __shfl_xor(s, 16); s += __shfl_xor(s, 32);
            if (fq == 0) ss[(size_t)row * 16 + (col0 >> 6)] = s; }
    }
};
struct EpiFfn {
    bf16_t* H; const float* rs;
    __device__ __forceinline__ void operator()(const Acc& acc, int row0, int col0, int fr, int fq) const {
#pragma unroll
        for (int m = 0; m < 4; ++m) { const int row = row0 + m * 16 + fr; const float r = rs[row]; bf16_t* rowp = H + (size_t)row * FFH + (col0 >> 1) + 4 * fq;
#pragma unroll
            for (int i = 0; i < 2; ++i) { const f32x4 gv = acc[m][2 * i] * r, uv = acc[m][2 * i + 1] * r; f32x4 h;
#pragma unroll
                for (int j = 0; j < 4; ++j) h[j] = gv[j] * sigmoidf_(gv[j]) * uv[j];
                *(u32x2*)(rowp + i * 16) = pack4(h); } }
    }
};
}

namespace pg8 {
constexpr int BM = 256, BK = 64, HALF = 128, HTB = HALF * BK * 2  , STAGE_BYTES = 8 * HTB, NXCD = 8, WGM = 8;

__host__ __device__ __forceinline__ int lds_byte(int r, int c) { const int st = (r >> 4) * 2 + (c >> 5), rr = r & 15, cc = c & 31, ob = rr * 64 + cc * 2; return st * 1024 + (ob ^ (((ob >> 9) & 1) << 5)); }
__host__ __device__ __forceinline__ void stage_rc(int b, int& R, int& C) { const int st = b / 1024, sb = b % 1024, swz = sb ^ (((sb >> 9) & 1) << 5); R = (st >> 1) * 16 + swz / 64; C = (st & 1) * 32 + (swz % 64) / 2; }
__host__ __device__ __forceinline__ int perm32(int rho) { const int n = rho >> 4, i = rho & 15; return 8 * (i >> 2) + 4 * n + (i & 3); }

struct Unit { int pm, pn, z; };
struct Gemm { const bf16_t* A; const bf16_t* Bt; int M, N, K; };

struct StaticOrder {
    int nM, nN, nwg, G, c;
    __host__ __device__ void init(int M, int N, int G_, int c_) { nM = M / BM; nN = N / BM; nwg = nM * nN; G = G_; c = c_; }
    __host__ __device__ bool next(int i, Unit& u) const {
        const long L = (long)i * G + c; if (L >= nwg) return false;
        int wgid = (int)L; { const int q = nwg / NXCD, r = nwg % NXCD, xcd = wgid % NXCD, off = wgid / NXCD; wgid = (xcd < r ? xcd * (q + 1) : r * (q + 1) + (xcd - r) * q) + off; }
        const int nig = WGM * nN, gid = wgid / nig, fm = gid * WGM, gsz = (nM - fm) < WGM ? (nM - fm) : WGM;
        u.pm = fm + ((wgid % nig) % gsz); u.pn = (wgid % nig) / gsz; u.z = 0; return true;
    }
    __device__ __forceinline__ void a_ready(const Unit&) const {}
    __device__ __forceinline__ void done(const Unit&) const {}
    __device__ __forceinline__ size_t aoff(const Unit&) const { return 0; }
    __device__ __forceinline__ size_t boff(const Unit&) const { return 0; }
};
struct Grouped3Order {
    StaticOrder so; size_t a1, a2, bstep;
    __device__ __forceinline__ bool next(int i, Unit& u) const { const int t = i / 3; if (!so.next(t, u)) return false; u.z = i - 3 * t; return true; }
    __device__ __forceinline__ void a_ready(const Unit&) const {}
    __device__ __forceinline__ void done(const Unit&) const {}
    __device__ __forceinline__ size_t aoff(const Unit& u) const { return u.z == 0 ? 0 : (u.z == 1 ? a1 : a2); }
    __device__ __forceinline__ size_t boff(const Unit& u) const { return (size_t)u.z * bstep; }
};
template <class Epi, class Sched, bool ALIGN_EPI = false, bool SP2 = false>
__device__ __forceinline__ void gemm_phase(LAS unsigned char* lds, const Gemm g, const Sched& S, const Epi& E) {
    int tid = threadIdx.x; asm volatile("" : "+v"(tid));
    const int wid = __builtin_amdgcn_readfirstlane(tid >> 6), lane = tid & 63, wr = wid >> 2, wc = wid & 3, fr = lane & 15, fq = lane >> 4;
    const int K = g.K, nt = K / BK;
    unsigned voffA[2], voffB[2];
#pragma unroll
    for (int i = 0; i < 2; ++i) { int R, C; stage_rc(tid * 16 + i * 8192, R, C); const int Rb = Epi::PERM ? ((R & ~31) + perm32(R & 31)) : R;
        voffA[i] = (unsigned)(R * K + C) * 2u; voffB[i] = (unsigned)(Rb * K + C) * 2u; }
    const size_t kstep = (size_t)(BK * 2);
    const size_t hstep = (size_t)HALF * K * 2;
    const size_t tstep = 2 * hstep;
    const unsigned ldsw = (unsigned)wid * 1024u;
    const int aoff = lds_byte(wr * 64 + fr, fq * 8), boff = lds_byte(wc * 32 + fr, fq * 8);
#define PG8_SA(b, h) (((b) * 2 + (h)) * HTB)
#define PG8_SB(b, h) ((4 + (b) * 2 + (h)) * HTB)
#define PG8_STAGE(bufoff, gbase, voff) do { _Pragma("unroll") for (int _i = 0; _i < 2; ++_i) \
        __builtin_amdgcn_global_load_lds((const unsigned*)((const char*)(gbase) + (voff)[_i]), (LAS unsigned*)(lds + (bufoff) + ldsw + _i * 8192), 16, 0, 0); } while (0)
#define PG8_LDA(dst, b, h) do { _Pragma("unroll") for (int m = 0; m < 4; ++m) _Pragma("unroll") for (int k = 0; k < 2; ++k) dst[m][k] = *(const LAS bf16x8*)(lds + PG8_SA(b, h) + aoff + m * 2048 + k * 1024); } while (0)
#define PG8_LDB(dst, b, h) do { _Pragma("unroll") for (int n = 0; n < 2; ++n) _Pragma("unroll") for (int k = 0; k < 2; ++k) dst[n][k] = *(const LAS bf16x8*)(lds + PG8_SB(b, h) + boff + n * 2048 + k * 1024); } while (0)
#define PG8_MMA(ai, bj, At, Bt) do { __builtin_amdgcn_s_setprio(1); _Pragma("unroll") for (int m = 0; m < 4; ++m) _Pragma("unroll") for (int n = 0; n < 2; ++n) _Pragma("unroll") for (int k = 0; k < 2; ++k) \
        acc[ai][bj][m][n] = __builtin_amdgcn_mfma_f32_16x16x32_bf16(Bt[n][k], At[m][k], acc[ai][bj][m][n], 0, 0, 0); __builtin_amdgcn_s_setprio(0); } while (0)
#define PG8_WAIT_V(n) asm volatile("s_waitcnt vmcnt(" #n ")" ::: "memory")
#define PG8_WAIT_L(n) asm volatile("s_waitcnt lgkmcnt(" #n ")" ::: "memory")
#define PG8_BAR __builtin_amdgcn_s_barrier()
#define PG8_SCHED __builtin_amdgcn_sched_barrier(0)
    Unit cur, nxt; int ui = 0;
    if (!S.next(0, cur)) return;
    f32x4 acc[2][2][4][2];
#pragma unroll
    for (int a = 0; a < 2; ++a)
#pragma unroll
        for (int b = 0; b < 2; ++b)
#pragma unroll
            for (int m = 0; m < 4; ++m)
#pragma unroll
                for (int n = 0; n < 2; ++n) acc[a][b][m][n] = (f32x4){0.f, 0.f, 0.f, 0.f};
    bf16x8 At[4][2], B0[2][2], B1[2][2];
    const char* cA = (const char*)g.A + S.aoff(cur) + (size_t)cur.pm * tstep; const char* cB = (const char*)g.Bt + S.boff(cur) + (size_t)cur.pn * tstep;
    S.a_ready(cur);
    if constexpr (SP2) {
        PG8_STAGE(PG8_SB(0, 0), cB, voffB); PG8_STAGE(PG8_SB(0, 1), cB + hstep, voffB); PG8_STAGE(PG8_SA(0, 0), cA, voffA); PG8_STAGE(PG8_SA(0, 1), cA + hstep, voffA);
        if (wr == 1) PG8_BAR;
        PG8_WAIT_V(2); PG8_BAR;
        PG8_STAGE(PG8_SB(1, 0), cB + kstep, voffB); PG8_STAGE(PG8_SA(1, 0), cA + kstep, voffA); PG8_STAGE(PG8_SB(1, 1), cB + hstep + kstep, voffB);
        PG8_WAIT_V(6); PG8_BAR;
    } else {
        PG8_STAGE(PG8_SB(0, 0), cB, voffB); PG8_STAGE(PG8_SA(0, 0), cA, voffA); PG8_STAGE(PG8_SB(0, 1), cB + hstep, voffB); PG8_STAGE(PG8_SA(0, 1), cA + hstep, voffA);
        if (wr == 1) PG8_BAR;
        PG8_WAIT_V(4); PG8_BAR;
        PG8_STAGE(PG8_SB(1, 0), cB + kstep, voffB); PG8_STAGE(PG8_SA(1, 0), cA + kstep, voffA); PG8_STAGE(PG8_SB(1, 1), cB + hstep + kstep, voffB);
        PG8_WAIT_V(6); PG8_BAR;
    }
    for (;;) {
        const bool has_next = S.next(ui + 1, nxt);
        const char* nA = has_next ? (const char*)g.A + S.aoff(nxt) + (size_t)nxt.pm * tstep : cA; const char* nB = has_next ? (const char*)g.Bt + S.boff(nxt) + (size_t)nxt.pn * tstep : cB;
        for (int t = 0; t < nt; t += 2) {
            const bool last = (t == nt - 2);
            const char* a1 = cA + (size_t)(t + 1) * kstep;
            const char* a2 = last ? nA : cA + (size_t)(t + 2) * kstep; const char* b2 = last ? nB : cB + (size_t)(t + 2) * kstep;
            const char* a3 = a2 + kstep; const char* b3 = b2 + kstep;
            if (last && has_next) S.a_ready(nxt);
            if constexpr (SP2) {
            PG8_LDB(B0, 0, 0); PG8_LDB(B1, 0, 1); PG8_SCHED; PG8_LDA(At, 0, 0); PG8_STAGE(PG8_SA(1, 1), a1 + hstep, voffA);
            PG8_WAIT_V(8); PG8_WAIT_L(0); PG8_BAR; PG8_MMA(0, 0, At, B0); PG8_MMA(0, 1, At, B1); PG8_BAR; PG8_SCHED;
            PG8_LDA(At, 0, 1); PG8_STAGE(PG8_SB(0, 0), b2, voffB); PG8_STAGE(PG8_SB(0, 1), b2 + hstep, voffB); PG8_STAGE(PG8_SA(0, 0), a2, voffA);
            PG8_WAIT_V(8); PG8_WAIT_L(0); PG8_BAR; PG8_MMA(1, 0, At, B0); PG8_MMA(1, 1, At, B1); PG8_BAR; PG8_SCHED;
            PG8_LDB(B0, 1, 0); PG8_LDB(B1, 1, 1); PG8_SCHED; PG8_LDA(At, 1, 0); PG8_STAGE(PG8_SA(0, 1), a2 + hstep, voffA);
            PG8_WAIT_V(8); PG8_WAIT_L(0); PG8_BAR; PG8_MMA(0, 0, At, B0); PG8_MMA(0, 1, At, B1); PG8_BAR; PG8_SCHED;
            PG8_LDA(At, 1, 1); PG8_STAGE(PG8_SB(1, 0), b3, voffB); PG8_STAGE(PG8_SB(1, 1), b3 + hstep, voffB); PG8_STAGE(PG8_SA(1, 0), a3, voffA);
            PG8_WAIT_V(8); PG8_WAIT_L(0); PG8_BAR; PG8_MMA(1, 0, At, B0); PG8_MMA(1, 1, At, B1); PG8_BAR; PG8_SCHED;
            } else {
            PG8_LDB(B0, 0, 0); PG8_SCHED; PG8_LDA(At, 0, 0); PG8_STAGE(PG8_SA(1, 1), a1 + hstep, voffA);
            PG8_WAIT_L(8); PG8_BAR; PG8_WAIT_L(0); PG8_MMA(0, 0, At, B0); PG8_BAR; PG8_SCHED;
            PG8_LDB(B1, 0, 1); PG8_STAGE(PG8_SB(0, 0), b2, voffB);
            PG8_BAR; PG8_WAIT_L(0); PG8_MMA(0, 1, At, B1); PG8_BAR;
            PG8_LDA(At, 0, 1); PG8_STAGE(PG8_SA(0, 0), a2, voffA);
            PG8_BAR; PG8_WAIT_L(0); PG8_MMA(1, 0, At, B0); PG8_BAR; PG8_SCHED;
            PG8_STAGE(PG8_SB(0, 1), b2 + hstep, voffB);
            PG8_WAIT_V(6); PG8_BAR; PG8_MMA(1, 1, At, B1); PG8_BAR;
            PG8_LDB(B0, 1, 0); PG8_SCHED; PG8_LDA(At, 1, 0); PG8_STAGE(PG8_SA(0, 1), a2 + hstep, voffA);
            PG8_WAIT_L(8); PG8_BAR; PG8_WAIT_L(0); PG8_MMA(0, 0, At, B0); PG8_BAR; PG8_SCHED;
            PG8_LDB(B1, 1, 1); PG8_STAGE(PG8_SB(1, 0), b3, voffB);
            PG8_BAR; PG8_WAIT_L(0); PG8_MMA(0, 1, At, B1); PG8_BAR;
            PG8_LDA(At, 1, 1); PG8_STAGE(PG8_SA(1, 0), a3, voffA);
            PG8_BAR; PG8_WAIT_L(0); PG8_MMA(1, 0, At, B0); PG8_BAR; PG8_SCHED;
            PG8_STAGE(PG8_SB(1, 1), b3 + hstep, voffB);
            PG8_WAIT_V(6); PG8_BAR; PG8_MMA(1, 1, At, B1); PG8_BAR;
            }
        }
        if constexpr (ALIGN_EPI) { if (wr == 0) PG8_BAR; }
        if constexpr (!Epi::AFTER_DRAIN) { E(acc, cur, wr, wc, fr, fq); S.done(cur); }
        if (!has_next) break;
#pragma unroll
        for (int a = 0; a < 2; ++a)
#pragma unroll
            for (int b = 0; b < 2; ++b)
#pragma unroll
                for (int m = 0; m < 4; ++m)
#pragma unroll
                    for (int n = 0; n < 2; ++n) acc[a][b][m][n] = (f32x4){0.f, 0.f, 0.f, 0.f};
        cur = nxt; cA = nA; cB = nB; ++ui;
        if constexpr (ALIGN_EPI) { if (wr == 1) PG8_BAR; }
    }
    PG8_WAIT_V(0);
    if constexpr (!ALIGN_EPI) { if (wr == 0) PG8_BAR; }
    PG8_BAR;
#undef PG8_SA
#undef PG8_SB
#undef PG8_STAGE
#undef PG8_LDA
#undef PG8_LDB
#undef PG8_MMA
#undef PG8_WAIT_V
#undef PG8_WAIT_L
#undef PG8_BAR
#undef PG8_SCHED
}

typedef const f32x4 (&AccRef)[2][2][4][2];
__device__ __forceinline__ u32x4 pack8(f32x4 v0, f32x4 v1) { u32x4 w; w.x = cvtpk(v0[0], v0[1]); w.y = cvtpk(v0[2], v0[3]); w.z = cvtpk(v1[0], v1[1]); w.w = cvtpk(v1[2], v1[3]); return w; }
struct EpiMix {
    static constexpr bool PERM = true, AFTER_DRAIN = false;
    bf16_t* U; const float* rs;
    __device__ __forceinline__ void operator()(AccRef acc, const Unit& u, int wr, int wc, int fr, int fq) const {
        const int row0 = u.pm * BM + wr * 64 + fr; const int colt = u.pn * BM; const int sec = colt >> 9;
        float rv[2][4];
#pragma unroll
        for (int ai = 0; ai < 2; ++ai)
#pragma unroll
            for (int m = 0; m < 4; ++m) rv[ai][m] = rs[row0 + ai * HALF + m * 16];
        if (sec == S_CA || sec == S_CG) {
            bf16_t* base = U + (size_t)S_CA * SEC_ELEMS + ((colt - 1536 + wc * 32 + 8 * fq) >> 1);
#pragma unroll
            for (int ai = 0; ai < 2; ++ai)
#pragma unroll
                for (int m = 0; m < 4; ++m) { const int row = row0 + ai * HALF + m * 16; const float r = rv[ai][m]; bf16_t* rowp = base + (size_t)row * 512;
#pragma unroll
                    for (int bj = 0; bj < 2; ++bj) { const f32x4 av = acc[ai][bj][m][0] * r, gv = acc[ai][bj][m][1] * r; f32x4 h;
#pragma unroll
                        for (int j = 0; j < 4; ++j) h[j] = av[j] * sigmoidf_(gv[j]);
                        u32x2 w; w.x = cvtpk(h[0], h[1]); w.y = cvtpk(h[2], h[3]); *(u32x2*)(rowp + bj * 64) = w; } }
            return;
        }
        bf16_t* base = U + (size_t)sec * SEC_ELEMS; const float sc = (sec == S_NAQ || sec == S_DQ) ? QSCALE : 1.f;
        const int col0 = (colt & 511) + wc * 32 + 8 * fq;
#pragma unroll
        for (int ai = 0; ai < 2; ++ai)
#pragma unroll
            for (int m = 0; m < 4; ++m) { const int row = row0 + ai * HALF + m * 16; const float r = rv[ai][m] * sc; bf16_t* rowp = base + (size_t)row * 512 + col0;
#pragma unroll
                for (int bj = 0; bj < 2; ++bj) *(u32x4*)(rowp + bj * HALF) = pack8(acc[ai][bj][m][0] * r, acc[ai][bj][m][1] * r); }
    }
};
struct EpiY {
    static constexpr bool PERM = true, AFTER_DRAIN = false;
    bf16_t* Y; float* ss;
    __device__ __forceinline__ void operator()(AccRef acc, const Unit& u, int wr, int wc, int fr, int fq) const {
        const int row0 = u.pm * BM + wr * 64 + fr; const int col0 = u.pn * BM + wc * 32 + 8 * fq;
#pragma unroll
        for (int ai = 0; ai < 2; ++ai)
#pragma unroll
            for (int m = 0; m < 4; ++m) { const int row = row0 + ai * HALF + m * 16; bf16_t* rowp = Y + (size_t)row * DM + col0;
#pragma unroll
                for (int bj = 0; bj < 2; ++bj) { const f32x4 v0 = acc[ai][bj][m][0], v1 = acc[ai][bj][m][1];
                    float s = (v0[0] * v0[0] + v0[1] * v0[1]) + (v0[2] * v0[2] + v0[3] * v0[3]) + (v1[0] * v1[0] + v1[1] * v1[1]) + (v1[2] * v1[2] + v1[3] * v1[3]);
                    *(u32x4*)(rowp + bj * HALF) = pack8(v0, v1);
                    s += __shfl_xor(s, 16); s += __shfl_xor(s, 32);
                    if (fq == 0) ss[(size_t)row * 32 + u.pn * 8 + bj * 4 + wc] = s; } }
    }
};
struct EpiFfn {
    static constexpr bool PERM = true, AFTER_DRAIN = false;
    bf16_t* H; const float* rs;
    __device__ __forceinline__ void operator()(AccRef acc, const Unit& u, int wr, int wc, int fr, int fq) const {
        const int row0 = u.pm * BM + wr * 64 + fr; const int col0 = u.pn * 128 + wc * 16 + 4 * fq;
        float rv[2][4];
#pragma unroll
        for (int ai = 0; ai < 2; ++ai)
#pragma unroll
            for (int m = 0; m < 4; ++m) rv[ai][m] = rs[row0 + ai * HALF + m * 16];
        const int sel = fq & 1;
#pragma unroll
        for (int ai = 0; ai < 2; ++ai)
#pragma unroll
            for (int m = 0; m < 4; ++m) { const int row = row0 + ai * HALF + m * 16; const float r = rv[ai][m]; bf16_t* rowp = H + (size_t)row * FFH + col0;
                u32x2 w[2];
#pragma unroll
                for (int bj = 0; bj < 2; ++bj) { const f32x4 gv = acc[ai][bj][m][0] * r, uv = acc[ai][bj][m][1] * r; f32x4 h;
#pragma unroll
                    for (int j = 0; j < 4; ++j) h[j] = gv[j] * sigmoidf_(gv[j]) * uv[j];
                    w[bj].x = cvtpk(h[0], h[1]); w[bj].y = cvtpk(h[2], h[3]); }
                auto sx = __builtin_amdgcn_permlane16_swap(w[0].x, w[1].x, false, false); auto sy = __builtin_amdgcn_permlane16_swap(w[0].y, w[1].y, false, false);
                u32x4 o; o.x = sx[0]; o.y = sy[0]; o.z = sx[1]; o.w = sy[1];
                *(u32x4*)(rowp + sel * (64 - 4)) = o; }
    }
};
struct EpiGate {
    static constexpr bool PERM = true, AFTER_DRAIN = false;
    u32x4* g01; u32x4* g2; const float* rs; const float* bias;
    __device__ __forceinline__ void operator()(AccRef acc, const Unit& u, int wr, int wc, int fr, int fq) const {
        const int row0 = u.pm * BM + wr * 64 + fr; const int col0 = u.pn * BM + wc * 32 + 8 * fq;
        int t_ = threadIdx.x; asm volatile("" : "+v"(t_));
        const int br = u.pn >> 2;
        u32x4* slot = (br < 2 ? g01 + (size_t)br * (1280u * 16u * 512u) : g2) + (size_t)(u.pm * 4 + (u.pn & 3)) * (16 * 512) + t_;
        float rv[2][4];
#pragma unroll
        for (int ai = 0; ai < 2; ++ai)
#pragma unroll
            for (int m = 0; m < 4; ++m) rv[ai][m] = rs[row0 + ai * HALF + m * 16];
#pragma unroll
        for (int bj = 0; bj < 2; ++bj) { const f32x4 b0 = *(const f32x4*)(bias + col0 + bj * HALF), b1 = *(const f32x4*)(bias + col0 + bj * HALF + 4);
#pragma unroll
            for (int ai = 0; ai < 2; ++ai)
#pragma unroll
                for (int m = 0; m < 4; ++m) { const float r = rv[ai][m];
                    f32x4 v0 = acc[ai][bj][m][0] * r + b0, v1 = acc[ai][bj][m][1] * r + b1;
#pragma unroll
                    for (int j = 0; j < 4; ++j) { v0[j] = sigmoidf_(v0[j]); v1[j] = sigmoidf_(v1[j]); }
                    slot[(size_t)((ai * 4 + m) * 2 + bj) * 512] = pack8(v0, v1); } }
    }
};
struct EpiProj {
    static constexpr bool PERM = true, AFTER_DRAIN = false;
    const u32x4* g01; const u32x4* g2; bf16_t* merged;
    __device__ __forceinline__ void operator()(AccRef acc, const Unit& u, int wr, int wc, int fr, int fq) const {
        const int row0 = u.pm * BM + wr * 64 + fr; const int col0 = u.pn * BM + wc * 32 + 8 * fq;
        int t_ = threadIdx.x; asm volatile("" : "+v"(t_));
        const bool first = (u.z == 0);
        const u32x4* slot = (u.z < 2 ? g01 + (size_t)u.z * (1280u * 16u * 512u) : g2) + (size_t)(u.pm * 4 + u.pn) * (16 * 512) + t_;
#pragma unroll
        for (int ai = 0; ai < 2; ++ai) {
            u32x4 gw[4][2], ow[4][2];
#pragma unroll
            for (int m = 0; m < 4; ++m)
#pragma unroll
                for (int bj = 0; bj < 2; ++bj) { gw[m][bj] = slot[(size_t)((ai * 4 + m) * 2 + bj) * 512];
                    if (!first) ow[m][bj] = *(const u32x4*)(merged + (size_t)(row0 + ai * HALF + m * 16) * DM + col0 + bj * HALF); }
#pragma unroll
            for (int m = 0; m < 4; ++m) { bf16_t* rowp = merged + (size_t)(row0 + ai * HALF + m * 16) * DM + col0;
#pragma unroll
                for (int bj = 0; bj < 2; ++bj) { const u32x4 g = gw[m][bj];
                    f32x4 v0 = (f32x4){bflo(g.x), bfhi(g.x), bflo(g.y), bfhi(g.y)} * acc[ai][bj][m][0], v1 = (f32x4){bflo(g.z), bfhi(g.z), bflo(g.w), bfhi(g.w)} * acc[ai][bj][m][1];
                    if (!first) { const u32x4 o = ow[m][bj];
                        v0 += (f32x4){bflo(o.x), bfhi(o.x), bflo(o.y), bfhi(o.y)}; v1 += (f32x4){bflo(o.z), bfhi(o.z), bflo(o.w), bfhi(o.w)}; }
                    *(u32x4*)(rowp + bj * HALF) = pack8(v0, v1); } }
        }
    }
};
}

__device__ __forceinline__ unsigned offa(unsigned row, unsigned ch) { return 2048u * (row >> 3) + 512u * (ch >> 2) + 64u * (row & 7) + 16u * ((ch & 3) ^ ((row >> 2) & 3)); }
__device__ __forceinline__ int crow(int r, int hi) { return (r & 3) + 8 * (r >> 2) + 4 * hi; }
typedef short v4i16_t __attribute__((ext_vector_type(4)));
__device__ __forceinline__ s16x4 vtr(const LAS unsigned char* p) { return __builtin_bit_cast(s16x4, __builtin_amdgcn_ds_read_tr16_b64_v4i16((LAS v4i16_t*)p)); }
__device__ __forceinline__ unsigned kbase_of(int lane) { const unsigned r32 = lane & 31, hi = lane >> 5; return 2048u * (r32 >> 3) + 64u * (r32 & 7) + 16u * (hi ^ ((r32 >> 2) & 3)); }
__device__ __forceinline__ unsigned vbase_of(int lane) { const unsigned hi = lane >> 5, blk = (lane >> 4) & 1, q4 = (lane & 15) >> 2, p = lane & 3; return 64u * (4 * hi + q4) + 16u * ((2 * blk + (p >> 1)) ^ hi) + 8u * (p & 1); }
#define KFRAG(Kt, kb0, kb1, kh, c, s) (*(const LAS bf16x8*)((Kt) + (((s) & 1) ? (kb1) : (kb0)) + 8192 * (kh) + 512 * (2 * (c) + ((s) >> 1))))
__device__ __forceinline__ bf16x8 vfrag(const LAS unsigned char* Vt, unsigned vb0, unsigned vb1, int ks, int c4) {
    const s16x4 lo = vtr(Vt + vb0 + 4096 * ks + 512 * c4);
    const s16x4 hh = vtr(Vt + vb1 + 4096 * ks + 2048 + 512 * c4);
    return (bf16x8){lo[0], lo[1], lo[2], lo[3], hh[0], hh[1], hh[2], hh[3]};
}
__device__ __forceinline__ float rowmax32(const f32x16& a, const f32x16& b) {
    float m0 = fmaxf(a[0], b[0]), m1 = fmaxf(a[1], b[1]);
#pragma unroll
    for (int r = 2; r < 16; r += 2) { m0 = fmaxf(m0, fmaxf(a[r], b[r])); m1 = fmaxf(m1, fmaxf(a[r + 1], b[r + 1])); }
    const float m = fmaxf(m0, m1);
    auto rr = __builtin_amdgcn_permlane32_swap(__float_as_uint(m), __float_as_uint(m), false, false);
    return fmaxf(__uint_as_float(rr[0]), __uint_as_float(rr[1]));
}
__device__ __forceinline__ float xhalf_sum(float v) {
    auto rr = __builtin_amdgcn_permlane32_swap(__float_as_uint(v), __float_as_uint(v), false, false);
    return __uint_as_float(rr[0]) + __uint_as_float(rr[1]);
}
__device__ __forceinline__ float exp_pack(f32x16& s0, f32x16& s1, float mm, bf16x8* P) {
    float sum0 = 0.f, sum1 = 0.f;
#pragma unroll
    for (int r = 0; r < 16; ++r) { s0[r] = __builtin_amdgcn_exp2f(s0[r] - mm); s1[r] = __builtin_amdgcn_exp2f(s1[r] - mm); sum0 += s0[r]; sum1 += s1[r]; }
#pragma unroll
    for (int sp = 0; sp < 2; ++sp) {
        u32x4 w0, w1;
        w0.x = cvtpk(s0[8 * sp + 0], s0[8 * sp + 1]); w0.y = cvtpk(s0[8 * sp + 2], s0[8 * sp + 3]); w0.z = cvtpk(s0[8 * sp + 4], s0[8 * sp + 5]); w0.w = cvtpk(s0[8 * sp + 6], s0[8 * sp + 7]);
        w1.x = cvtpk(s1[8 * sp + 0], s1[8 * sp + 1]); w1.y = cvtpk(s1[8 * sp + 2], s1[8 * sp + 3]); w1.z = cvtpk(s1[8 * sp + 4], s1[8 * sp + 5]); w1.w = cvtpk(s1[8 * sp + 6], s1[8 * sp + 7]);
        P[sp] = __builtin_bit_cast(bf16x8, w0); P[2 + sp] = __builtin_bit_cast(bf16x8, w1);
    }
    return sum0 + sum1;
}
__device__ __forceinline__ void chunk_rc(int n, int& row, int& ch) { row = ((n >> 5) << 1) | ((n >> 2) & 1); ch = (((n >> 3) & 3) << 2) | (n & 3); }

__device__ __forceinline__ size_t dma_goff(int pc, int lane, int pitch) {
    const unsigned o = pc * 1024u + lane * 16u; const unsigned r8 = o >> 11, chh = (o >> 9) & 3, rl = (o >> 6) & 7, x = (o >> 4) & 3;
    const unsigned row = 8 * r8 + rl, ch = 4 * chh + (x ^ ((row >> 2) & 3));
    return (size_t)row * pitch + ch * 8;
}
#define GLDS16(gptr, ldsptr) __builtin_amdgcn_global_load_lds((const unsigned*)(gptr), (LAS unsigned*)(ldsptr), 16, 0, 0)

template <bool HAS_QK, bool HAS_PV>
__device__ __forceinline__ void diff_step(const LAS unsigned char* Kt, const LAS unsigned char* Vp, const LAS float* tab, const bf16x8 (&qf)[4], f32x16 (&O)[4], bf16x8 (&P)[4],
                                          float& mrun, float& lrun, float beta, int ib0, unsigned kb0, unsigned kb1, unsigned vb0, unsigned vb1, bool NEAR, bool first = false) {
    f32x16 s0, s1;
    if (HAS_QK) {
        const float c0 = beta - mrun;
#pragma unroll
        for (int r = 0; r < 16; ++r) { s0[r] = c0; s1[r] = c0; }
#pragma unroll
        for (int s4 = 0; s4 < 4; ++s4) {
            const bf16x8 a0 = KFRAG(Kt, kb0, kb1, 0, 0, s4), a1 = KFRAG(Kt, kb0, kb1, 1, 0, s4);
            s0 = __builtin_amdgcn_mfma_f32_32x32x16_bf16(a0, qf[s4], s0, 0, 0, 0);
            s1 = __builtin_amdgcn_mfma_f32_32x32x16_bf16(a1, qf[s4], s1, 0, 0, 0);
        }
    }
    if (HAS_PV) {
#pragma unroll
        for (int ks = 0; ks < 2; ++ks)
#pragma unroll
            for (int c4 = 0; c4 < 4; ++c4) { const bf16x8 vf = vfrag(Vp, vb0, vb1, ks, c4); O[c4] = __builtin_amdgcn_mfma_f32_32x32x16_bf16(vf, P[ks], O[c4], 0, 0, 0); }
    }
    float f = 1.f; bool need = false;
    if (HAS_QK) {
        if (NEAR) {
#pragma unroll
            for (int r = 0; r < 16; ++r) { int i0 = ib0 + (r & 3) + 8 * (r >> 2), i1 = i0 + 32; i0 = min(max(i0, 0), 256); i1 = min(max(i1, 0), 256); s0[r] += tab[i0]; s1[r] += tab[i1]; }
        }
        const float rm = rowmax32(s0, s1);
        need = first || __any(rm > 8.f);
        if (need) { const float dl = first ? rm : fmaxf(rm, 0.f); mrun += dl; f = first ? 1.f : __builtin_amdgcn_exp2f(-dl);
#pragma unroll
            for (int r = 0; r < 16; ++r) { s0[r] -= dl; s1[r] -= dl; } }
    }
    if (HAS_PV) {
#pragma unroll
        for (int ks = 2; ks < 4; ++ks)
#pragma unroll
            for (int c4 = 0; c4 < 4; ++c4) { const bf16x8 vf = vfrag(Vp, vb0, vb1, ks, c4); O[c4] = __builtin_amdgcn_mfma_f32_32x32x16_bf16(vf, P[ks], O[c4], 0, 0, 0); }
    }
    if (HAS_QK) {
        float sum0 = 0.f, sum1 = 0.f;
#pragma unroll
        for (int r = 0; r < 16; ++r) { s0[r] = __builtin_amdgcn_exp2f(s0[r]); s1[r] = __builtin_amdgcn_exp2f(s1[r]); sum0 += s0[r]; sum1 += s1[r]; }
#pragma unroll
        for (int sp = 0; sp < 2; ++sp) {
            u32x4 w0, w1;
            w0.x = cvtpk(s0[8 * sp + 0], s0[8 * sp + 1]); w0.y = cvtpk(s0[8 * sp + 2], s0[8 * sp + 3]); w0.z = cvtpk(s0[8 * sp + 4], s0[8 * sp + 5]); w0.w = cvtpk(s0[8 * sp + 6], s0[8 * sp + 7]);
            w1.x = cvtpk(s1[8 * sp + 0], s1[8 * sp + 1]); w1.y = cvtpk(s1[8 * sp + 2], s1[8 * sp + 3]); w1.z = cvtpk(s1[8 * sp + 4], s1[8 * sp + 5]); w1.w = cvtpk(s1[8 * sp + 6], s1[8 * sp + 7]);
            P[sp] = __builtin_bit_cast(bf16x8, w0); P[2 + sp] = __builtin_bit_cast(bf16x8, w1);
        }
        if (need && !first) {
#pragma unroll
            for (int e = 0; e < 4; ++e) O[e] *= f;
        }
        lrun = lrun * f + (sum0 + sum1);
    }
}

__device__ __forceinline__ void diff_unit(LAS unsigned char* lds, const bf16_t* __restrict__ Kg, const bf16_t* __restrict__ Vg, bf16_t* QO,
                                          long R0, int S, int hd, int qblk, float lam, float oscale, const float* __restrict__ subg, int dry = 0) {
    int tid = threadIdx.x; asm volatile("" : "+v"(tid));
    const int lane = tid & 63, wid = __builtin_amdgcn_readfirstlane(tid >> 6), r32 = lane & 31, hi = lane >> 5;
    const int qg = wid >> 1, cmap = wid & 1;
    const LAS float* tab = (const LAS float*)(lds + LDS_TAB) + hd * 257;
    const int q0w = qblk * 128 + qg * 32;
    bf16_t* Qrow = QO + (size_t)(R0 + q0w + r32) * 512 + hd * 128;
    bf16x8 qf[4];
#pragma unroll
    for (int s = 0; s < 4; ++s) qf[s] = *(const bf16x8*)(Qrow + cmap * 64 + s * 16 + hi * 8);
    const bf16_t* kbase = Kg + (size_t)R0 * 512 + hd * 128;
    const bf16_t* vbase = Vg + (size_t)R0 * 512 + hd * 128;
    const size_t g0 = dma_goff(wid, lane, 512), g1 = dma_goff(wid + 8, lane, 512);
    const unsigned d0 = wid * 1024u, d1 = (wid + 8) * 1024u;
    const unsigned kb0 = kbase_of(lane), kb1 = kb0 ^ 32u, vb0 = vbase_of(lane), vb1 = vb0 ^ 32u;
    const int nt = S / 64;
#define DIFF_DMA2(st, boff) do { const size_t go = (size_t)(st) * 128 * 512; LAS unsigned char* b_ = lds + (boff); \
        GLDS16(kbase + go + g0, b_ + d0); GLDS16(kbase + go + g1, b_ + d1); GLDS16(vbase + go + g0, b_ + 16384 + d0); GLDS16(vbase + go + g1, b_ + 16384 + d1); \
        GLDS16(kbase + go + 64 * 512 + g0, b_ + 32768 + d0); GLDS16(kbase + go + 64 * 512 + g1, b_ + 32768 + d1); GLDS16(vbase + go + 64 * 512 + g0, b_ + 49152 + d0); GLDS16(vbase + go + 64 * 512 + g1, b_ + 49152 + d1); } while (0)
    DIFF_DMA2(0, 0);
    float mrun = 0.f, lrun = 0.f;
    f32x16 O[4]; bf16x8 P[4];
#pragma unroll
    for (int e = 0; e < 4; ++e) { O[e] = (f32x16){}; P[e] = (bf16x8){}; }
    const int qidx = q0w + r32;
    const int ibq = 128 + 4 * hi - qidx;
    const int ns = nt >> 1;
    __syncthreads();
    if (wid < 4) __builtin_amdgcn_s_setprio(1);
#pragma unroll 1
    for (int st = 0; st < ns; ++st) {
        const unsigned bb = (st & 1) * 65536u;
        if (st + 1 < ns) DIFF_DMA2(st + 1, ((st + 1) & 1) * 65536u);
        const LAS unsigned char* KA = lds + bb + cmap * 1024; const LAS unsigned char* VA = lds + bb + 16384;
        const LAS unsigned char* KB = lds + bb + 32768 + cmap * 1024; const LAS unsigned char* VB = lds + bb + 49152;
        { const int kq = st * 128;
          const bool farR = (kq - q0w - 31 >= 91), farL = (kq + 63 - q0w <= -91), nr = !(farR || farL);
          diff_step<true, false>(KA, VA, tab, qf, O, P, mrun, lrun, nr ? 0.f : (farR ? tab[256] : tab[0]), kq + ibq, kb0, kb1, vb0, vb1, nr, st == 0); }
        { const int kq = st * 128 + 64;
          const bool farR = (kq - q0w - 31 >= 91), farL = (kq + 63 - q0w <= -91), nr = !(farR || farL);
          diff_step<true, true>(KB, VA, tab, qf, O, P, mrun, lrun, nr ? 0.f : (farR ? tab[256] : tab[0]), kq + ibq, kb0, kb1, vb0, vb1, nr); }
        diff_step<false, true>(KB, VB, tab, qf, O, P, mrun, lrun, 0.f, 0, kb0, kb1, vb0, vb1, false);
        __syncthreads();
    }
#undef DIFF_DMA2
    __builtin_amdgcn_s_setprio(0);
    const float il = __builtin_amdgcn_rcpf(xhalf_sum(lrun));
    LAS f32x4* xb = (LAS f32x4*)(lds + qg * 16384) + lane;
    if (cmap == 1) {
        const float sc = il * lam;
#pragma unroll
        for (int e = 0; e < 4; ++e)
#pragma unroll
            for (int g = 0; g < 4; ++g) xb[(e * 4 + g) * 64] = (f32x4){O[e][4 * g + 0], O[e][4 * g + 1], O[e][4 * g + 2], O[e][4 * g + 3]} * sc;
    }
    __syncthreads();
    if (cmap == 0 && !dry) {
        bf16_t* Qrow2 = QO + (size_t)(R0 + q0w + r32) * 512 + hd * 128;
        float ssq = 0.f;
#pragma unroll
        for (int e = 0; e < 4; ++e)
#pragma unroll
            for (int g = 0; g < 4; ++g) { const f32x4 o1 = xb[(e * 4 + g) * 64];
#pragma unroll
                for (int j = 0; j < 4; ++j) { const float o = O[e][4 * g + j] * il - o1[j]; O[e][4 * g + j] = o; ssq += o * o; } }
        ssq = xhalf_sum(ssq);
        const float rn = rsqrtf(ssq * (1.f / 128.f) + EPS) * oscale;
#pragma unroll
        for (int e = 0; e < 4; ++e)
#pragma unroll
            for (int gp = 0; gp < 2; ++gp) { u32x2 w[2];
#pragma unroll
                for (int k = 0; k < 2; ++k) { const int g = 2 * gp + k; const int ecol = 32 * e + 8 * g + 4 * hi; const f32x4 gv = *(const f32x4*)(subg + ecol);
                    w[k].x = cvtpk(O[e][4 * g + 0] * rn * gv[0], O[e][4 * g + 1] * rn * gv[1]); w[k].y = cvtpk(O[e][4 * g + 2] * rn * gv[2], O[e][4 * g + 3] * rn * gv[3]); }
                auto sx = __builtin_amdgcn_permlane32_swap(w[0].x, w[1].x, false, false); auto sy = __builtin_amdgcn_permlane32_swap(w[0].y, w[1].y, false, false);
                u32x4 o; o.x = sx[0]; o.y = sy[0]; o.z = sx[1]; o.w = sy[1];
                *(u32x4*)(Qrow2 + 32 * e + 8 * (2 * gp + hi)) = o; }
    }
    __syncthreads();
}

__device__ __forceinline__ void na_unit(LAS unsigned char* lds, const bf16_t* __restrict__ Kg, const bf16_t* __restrict__ Vg, bf16_t* QO,
                                        long R0, int rows, int r0, int hpair, int dry = 0) {
    int tid = threadIdx.x; asm volatile("" : "+v"(tid));
    const int lane = tid & 63, wid = __builtin_amdgcn_readfirstlane(tid >> 6), r32 = lane & 31, hi = lane >> 5;
    const int rr = wid >> 2, hh = (wid >> 1) & 1, half = wid & 1, head = 2 * hpair + hh, r = r0 + rr;
    const LAS float* tab = (const LAS float*)(lds + LDS_TAB) + head * 465;
    int rs = r - 4; rs = rs < 0 ? 0 : (rs > rows - 8 ? rows - 8 : rs);
    int rs0 = r0 - 4; rs0 = rs0 < 0 ? 0 : (rs0 > rows - 8 ? rows - 8 : rs0);
    int rs1 = r0 - 3; rs1 = rs1 < 0 ? 0 : (rs1 > rows - 8 ? rows - 8 : rs1);
    const int nst = rs1 + 8 - rs0;
    const int c = 32 * half + r32;
    int cs = c - 8; cs = cs < 0 ? 0 : (cs > 48 ? 48 : cs);
    const unsigned long long wmask = 0xFFFFull << cs; const unsigned mlo = (unsigned)wmask, mhi = (unsigned)(wmask >> 32);
    const int ibase = 15 - c + 4 * hi;
    bf16_t* Qrow = QO + (size_t)(R0 + (size_t)r * 64 + c) * 512 + head * 64;
    bf16x8 qf[4];
#pragma unroll
    for (int s = 0; s < 4; ++s) qf[s] = *(const bf16x8*)(Qrow + s * 16 + hi * 8);
    const bf16_t* kbase = Kg + (size_t)(R0 + (size_t)rs0 * 64) * 512 + hpair * 128;
    const bf16_t* vbase = Vg + (size_t)(R0 + (size_t)rs0 * 64) * 512 + hpair * 128;
    const unsigned g0 = dma_goff(wid, lane, 512), g1 = dma_goff(wid + 8, lane, 512);
    const unsigned d0 = wid * 1024u, d1 = (wid + 8) * 1024u;
    const unsigned kb0 = kbase_of(lane), kb1 = kb0 ^ 32u, vb0 = vbase_of(lane), vb1 = vb0 ^ 32u;
#define NA_DMA(st, boff) do { const size_t go = (size_t)(st) * 64 * 512; LAS unsigned char* b_ = lds + (boff); \
        GLDS16(kbase + go + g0, b_ + d0); GLDS16(kbase + go + g1, b_ + d1); GLDS16(vbase + go + g0, b_ + 16384 + d0); GLDS16(vbase + go + g1, b_ + 16384 + d1); } while (0)
    const int nst2 = (nst + 1) >> 1;
    NA_DMA(0, 0); NA_DMA(1, 32768);
    __syncthreads();
    float mrun = -1e30f, lrun = 0.f;
    f32x16 O[2]; O[0] = (f32x16){}; O[1] = (f32x16){};
    if (wid >= 4) __builtin_amdgcn_s_setprio(1);
#pragma unroll 1
    for (int s2 = 0; s2 < nst2; ++s2) {
        const unsigned bb = (s2 & 1) * 65536u;
        if (s2 + 1 < nst2) { const unsigned nb = ((s2 + 1) & 1) * 65536u; NA_DMA(2 * s2 + 2, nb); if (2 * s2 + 3 < nst) NA_DMA(2 * s2 + 3, nb + 32768); }
#pragma unroll 1
        for (int sub = 0; sub < 2; ++sub) {
        const int st = 2 * s2 + sub;
        const LAS unsigned char* Kt = lds + bb + sub * 32768; const LAS unsigned char* Vt = Kt + 16384;
        const int ku = rs0 + st;
        if (st < nst && ku >= rs && ku < rs + 8) {
            f32x16 s0 = (f32x16){}, s1 = (f32x16){};
#pragma unroll
            for (int s4 = 0; s4 < 4; ++s4) {
                const bf16x8 a0 = KFRAG(Kt, kb0, kb1, 0, hh, s4), a1 = KFRAG(Kt, kb0, kb1, 1, hh, s4);
                s0 = __builtin_amdgcn_mfma_f32_32x32x16_bf16(a0, qf[s4], s0, 0, 0, 0);
                s1 = __builtin_amdgcn_mfma_f32_32x32x16_bf16(a1, qf[s4], s1, 0, 0, 0);
            }
            const LAS float* trow = tab + (ku - r + 7) * 31;
#pragma unroll
            for (int q = 0; q < 16; ++q) { const int ko = (q & 3) + 8 * (q >> 2);
                int i0 = ibase + ko, i1 = ibase + ko + 32; i0 = min(max(i0, 0), 30); i1 = min(max(i1, 0), 30);
                const float b0 = trow[i0], b1 = trow[i1];
                const float p0 = (float)((mlo >> (ko + 4 * hi)) & 1u), p1 = (float)((mhi >> (ko + 4 * hi)) & 1u);
                s0[q] = s0[q] + b0 + (p0 - 1.f) * 1e30f; s1[q] = s1[q] + b1 + (p1 - 1.f) * 1e30f; }
            const float rm = rowmax32(s0, s1);
            if (__any(rm > mrun + 8.f)) { const float mn = fmaxf(mrun, rm), f = __builtin_amdgcn_exp2f(mrun - mn); lrun *= f; mrun = mn; O[0] *= f; O[1] *= f; }
            bf16x8 P[4];
            lrun += exp_pack(s0, s1, mrun, P);
#pragma unroll
            for (int ks = 0; ks < 4; ++ks)
#pragma unroll
                for (int e = 0; e < 2; ++e) { const bf16x8 vf = vfrag(Vt, vb0, vb1, ks, 2 * hh + e); O[e] = __builtin_amdgcn_mfma_f32_32x32x16_bf16(vf, P[ks], O[e], 0, 0, 0); }
        }
        }
        __syncthreads();
    }
#undef NA_DMA
    __builtin_amdgcn_s_setprio(0);
    const float il = __builtin_amdgcn_rcpf(xhalf_sum(lrun));
    if (!dry) {
#pragma unroll
        for (int e = 0; e < 2; ++e)
#pragma unroll
            for (int gp = 0; gp < 2; ++gp) { u32x2 w[2];
#pragma unroll
                for (int k = 0; k < 2; ++k) { const int g = 2 * gp + k; w[k].x = cvtpk(O[e][4 * g + 0] * il, O[e][4 * g + 1] * il); w[k].y = cvtpk(O[e][4 * g + 2] * il, O[e][4 * g + 3] * il); }
                auto sx = __builtin_amdgcn_permlane32_swap(w[0].x, w[1].x, false, false); auto sy = __builtin_amdgcn_permlane32_swap(w[0].y, w[1].y, false, false);
                u32x4 o; o.x = sx[0]; o.y = sy[0]; o.z = sx[1]; o.w = sy[1];
                *(u32x4*)(Qrow + 32 * e + 8 * (2 * gp + hi)) = o; }
    }
}

__device__ __forceinline__ void conv_unit(LAS unsigned char* lds, const bf16_t* __restrict__ CA, const bf16_t* __restrict__ CG, bf16_t* __restrict__ OCV,
                                          const f32x2 (&w)[31], const f32x2 bv, const f32x4 (&lnp)[4], int tid,
                                          long R0, int S, int t0, bool preloaded, bool has_next, long nR0, int nS, int nt0) {
    const int lane = tid & 63, wid = tid >> 6;
    if (!preloaded) {
        u32x4 av[8];
#pragma unroll
        for (int it = 0; it < 8; ++it) { const int n = tid + it * 512; int row = n >> 6; row = row > 61 ? 61 : row; const int ch = n & 63; int tok = t0 - 15 + row; tok = tok < 0 ? 0 : (tok > S - 1 ? S - 1 : tok);
            av[it] = *(const u32x4*)(CA + (size_t)(R0 + tok) * 512 + ch * 8); }
#pragma unroll
        for (int it = 0; it < 8; ++it) { const int n = tid + it * 512; const int row = n >> 6, ch = n & 63; const int tok = t0 - 15 + row;
            u32x4 w = av[it]; if (tok < 0 || tok >= S) w = (u32x4){0u, 0u, 0u, 0u};
            if (row < 62) *(LAS u32x4*)(lds + (size_t)row * 1024 + ch * 16) = w; }
    }
    __syncthreads();
    {   const int cp = tid & 255, th = tid >> 8;
        for (int hf = 0; hf < 2; ++hf) {
            const int tb = 16 * th + 8 * hf;
            f32x2 acc[8];
#pragma unroll
            for (int i = 0; i < 8; ++i) acc[i] = bv;
            const LAS unsigned* xin = (const LAS unsigned*)lds + tb * 256 + cp;
#pragma unroll
            for (int j = 0; j < 38; ++j) { const unsigned xu = xin[j * 256]; const f32x2 x = {bflo(xu), bfhi(xu)};
#pragma unroll
                for (int i = 0; i < 8; ++i) { const int k = j - i; if (k >= 0 && k <= 30) acc[i] += w[k] * x; }
                if ((j & 3) == 3) asm volatile("" ::: "memory"); }
            LAS f32x2* co = (LAS f32x2*)(lds + 65536) + tb * 256 + cp;
#pragma unroll
            for (int i = 0; i < 8; ++i) co[i * 256] = acc[i];
        }
    }
    __syncthreads();
    u32x4 nav[8];
    if (has_next) {
#pragma unroll
        for (int it = 0; it < 8; ++it) { const int n = tid + it * 512; int row = n >> 6; row = row > 61 ? 61 : row; const int ch = n & 63; int tok = nt0 - 15 + row; tok = tok < 0 ? 0 : (tok > nS - 1 ? nS - 1 : tok);
            nav[it] = *(const u32x4*)(CA + (size_t)(nR0 + tok) * 512 + ch * 8); }
    }
    {
        const f32x4 g0 = lnp[0], g1 = lnp[1], b0 = lnp[2], b1 = lnp[3];
#pragma unroll
        for (int i = 0; i < 4; ++i) { const int tok = 4 * wid + i;
            const LAS f32x4* cr = (const LAS f32x4*)(lds + 65536 + (size_t)tok * 2048) + 2 * lane;
            f32x4 v0 = cr[0], v1 = cr[1];
            const float mean = wave_sum((v0[0] + v0[1]) + (v0[2] + v0[3]) + (v1[0] + v1[1]) + (v1[2] + v1[3])) * (1.f / 512.f);
            v0 = v0 - mean; v1 = v1 - mean;
            const float var = wave_sum((v0[0] * v0[0] + v0[1] * v0[1]) + (v0[2] * v0[2] + v0[3] * v0[3]) + (v1[0] * v1[0] + v1[1] * v1[1]) + (v1[2] * v1[2] + v1[3] * v1[3])) * (1.f / 512.f);
            const float rstd = rsqrtf(var + EPS);
            v0 = v0 * rstd * g0 + b0; v1 = v1 * rstd * g1 + b1;
#pragma unroll
            for (int j = 0; j < 4; ++j) { v0[j] = v0[j] * sigmoidf_(v0[j]); v1[j] = v1[j] * sigmoidf_(v1[j]); }
            { u32x4 w; w.x = cvtpk(v0[0], v0[1]); w.y = cvtpk(v0[2], v0[3]); w.z = cvtpk(v1[0], v1[1]); w.w = cvtpk(v1[2], v1[3]); *(u32x4*)(OCV + (size_t)(R0 + t0 + tok) * 512 + 8 * lane) = w; } }
    }
    if (has_next) {
#pragma unroll
        for (int it = 0; it < 8; ++it) { const int n = tid + it * 512; const int row = n >> 6, ch = n & 63; const int tok = nt0 - 15 + row;
            u32x4 w = nav[it]; if (tok < 0 || tok >= nS) w = (u32x4){0u, 0u, 0u, 0u};
            if (row < 62) *(LAS u32x4*)(lds + (size_t)row * 1024 + ch * 16) = w; }
    } else __syncthreads();
}

__device__ __forceinline__ int t5_bucket(int rel) {
    const int ret = rel > 0 ? 16 : 0; const int n = rel < 0 ? -rel : rel;
    if (n < 8) return ret + n;
    const float nf = (float)n;
    int large = 8 + (int)(logf(nf / 8.f) / 2.772588722239781f * 8.f);
    large = large > 15 ? 15 : large;
    return ret + large;
}
__device__ __forceinline__ void wprep_item(const float* __restrict__ W, int ldw, int K, bf16_t* WT, int nblk, int item, int mode, int coloff, const float* __restrict__ gain, LAS float* scr, int lane) {
    const int kb = item / nblk, nb = item % nblk, k0 = 64 * kb, n0 = 32 * nb;
    const int r8 = lane >> 3, c8 = lane & 7;
    const int np = n0 + 4 * c8;
    int sc;
    if (mode == 1) sc = ((np & 7) < 4) ? 4 * (np >> 3) + (np & 7) : FFH + 4 * (np >> 3) + (np & 7) - 4;
    else if (mode == 2 && np >= 1536 && np < 2560) { const int q = np - 1536; sc = ((q & 7) < 4) ? 1536 + 4 * (q >> 3) + (q & 7) : 2048 + 4 * (q >> 3) + (q & 7) - 4; }
    else sc = coloff + np;
#pragma unroll
    for (int i = 0; i < 8; ++i) { const int kk = 8 * i + r8; f32x4 v = *(const f32x4*)(W + (size_t)(k0 + kk) * ldw + sc); if (gain) v = v * gain[k0 + kk];
        LAS float* d = scr + kk * 33 + 4 * c8; d[0] = v[0]; d[1] = v[1]; d[2] = v[2]; d[3] = v[3]; }
    asm volatile("s_waitcnt lgkmcnt(0)" ::: "memory");
    const int c = lane & 7;
#pragma unroll
    for (int j = 0; j < 4; ++j) { const int n = (lane >> 3) + 8 * j; const LAS float* s = scr + (8 * c) * 33 + n;
        u32x4 o; o.x = cvtpk(s[0 * 33], s[1 * 33]); o.y = cvtpk(s[2 * 33], s[3 * 33]); o.z = cvtpk(s[4 * 33], s[5 * 33]); o.w = cvtpk(s[6 * 33], s[7 * 33]);
        *(u32x4*)(WT + (size_t)(n0 + n) * K + k0 + 8 * c) = o; }
    asm volatile("s_waitcnt lgkmcnt(0)" ::: "memory");
}

#define XB_TMO      128
#define XB_XCNT(j)  (256  + 64 * (j))
#define XB_XSUB(j)  (1280 + 64 * (j))
#define XB_XGEN(j)  (2304 + 64 * (j))
#define XB_TOP      3328
#define XB_TOPGEN   3392
#define XCD_BAR_WORDS 3456
#define XB_SPIN_CAP (1u << 22)

__device__ __forceinline__ unsigned xb_ld(unsigned* p)              { return __hip_atomic_load(p, __ATOMIC_RELAXED, __HIP_MEMORY_SCOPE_AGENT); }
__device__ __forceinline__ unsigned xb_add(unsigned* p, unsigned v) { return __hip_atomic_fetch_add(p, v, __ATOMIC_RELAXED, __HIP_MEMORY_SCOPE_AGENT); }
__device__ __forceinline__ unsigned xb_xcc_id() { return (unsigned)__builtin_amdgcn_s_getreg((3 << 11) | 20) & 0xFu; }
#define XB_SPIN(cond, bar) do { unsigned _sp = 0; while (cond) { __builtin_amdgcn_s_sleep(1); \
    if ((++_sp & 255u) == 0u) { if (xb_ld(&(bar)[XB_TMO])) break; if (_sp > XB_SPIN_CAP) { atomicAdd(&(bar)[XB_TMO], 1u); break; } } } } while (0)

struct XcdBarrier {
    unsigned* bar; unsigned x;
    volatile LAS unsigned* st;
};

__device__ __forceinline__ XcdBarrier xcd_barrier_post(unsigned* bar, volatile LAS unsigned* st) {
    XcdBarrier b; b.bar = bar; b.x = xb_xcc_id(); b.st = st;
    if (threadIdx.x == 0) (void)xb_add(&bar[XB_XCNT(b.x)], 1u);
    return b;
}
__device__ __forceinline__ void xcd_barrier_complete(unsigned* bar, unsigned x, unsigned& nloc, unsigned& nx) {
    const unsigned G = gridDim.x * gridDim.y * gridDim.z;
    unsigned sum, cnt, mine, sp = 0u;
    for (;;) {
        sum = 0u; cnt = 0u; mine = 0u;
#pragma unroll
        for (unsigned j = 0; j < 16; ++j) { const unsigned c = xb_ld(&bar[XB_XCNT(j)]); sum += c; cnt += (c > 0u) ? 1u : 0u; mine = (j == x) ? c : mine; }
        if (sum == G) break;
        __builtin_amdgcn_s_sleep(1);
        if ((++sp & 255u) == 0u) { if (xb_ld(&bar[XB_TMO])) break; if (sp > XB_SPIN_CAP) { atomicAdd(&bar[XB_TMO], 1u); break; } }
    }
    nloc = mine > 0u ? mine : 1u; nx = cnt > 0u ? cnt : 1u;
}

__device__ __forceinline__ void xcd_barrier(const XcdBarrier& b) {
    asm volatile("s_waitcnt vmcnt(0)" ::: "memory");
    __syncthreads();
    if (threadIdx.x == 0) {
        unsigned* bar = b.bar;
        __builtin_amdgcn_s_waitcnt(0);
        unsigned nloc = b.st[0], nx = b.st[1];
        if (nloc == 0u) { xcd_barrier_complete(bar, b.x, nloc, nx); b.st[0] = nloc; b.st[1] = nx; }
        const unsigned old = xb_add(&bar[XB_XSUB(b.x)], 1u);
        const unsigned gen = old / nloc;
        if (old + 1u == (gen + 1u) * nloc) {
            __builtin_amdgcn_fence(__ATOMIC_RELEASE, "agent");
            asm volatile("s_waitcnt vmcnt(0)" ::: "memory");
            const unsigned og = xb_add(&bar[XB_TOP], 1u);
            const unsigned tg = og / nx;
            if (og + 1u == (tg + 1u) * nx) xb_add(&bar[XB_TOPGEN], 1u);
            else XB_SPIN(xb_ld(&bar[XB_TOPGEN]) == tg, bar);
            __builtin_amdgcn_fence(__ATOMIC_ACQUIRE, "agent");
            xb_add(&bar[XB_XGEN(b.x)], 1u);
            asm volatile("s_waitcnt vmcnt(0)" ::: "memory");
        } else {
            XB_SPIN(xb_ld(&bar[XB_XGEN(b.x)]) == gen, bar);
            __builtin_amdgcn_fence(__ATOMIC_ACQUIRE, "agent");
            asm volatile("s_waitcnt vmcnt(0)" ::: "memory");
        }
    }
    __syncthreads();
}

struct Params {
    const float* in[20];
    float* out;
    unsigned char* ws;
    int ph_lo, ph_hi;
};
enum { I_XP = 0, I_XS, I_WIN, I_BGATE, I_RPB, I_DWW, I_DWB, I_CLG, I_CLB, I_LAM, I_SUBG, I_T5, I_WBR, I_WOUT, I_LMPRE, I_LMPOST, I_LFPRE, I_LFPOST, I_WF1, I_WF2 };

__device__ __forceinline__ void row_prep(const float* __restrict__ xrow, bf16_t* xbrow, float* rs, int row, int lane) {
    const f32x4* xr = (const f32x4*)xrow + lane; f32x4 v[4]; float s = 0.f;
#pragma unroll
    for (int j = 0; j < 4; ++j) { v[j] = xr[64 * j]; s += (v[j][0] * v[j][0] + v[j][1] * v[j][1]) + (v[j][2] * v[j][2] + v[j][3] * v[j][3]); }
    s = wave_sum(s);
    u32x2* o = (u32x2*)xbrow + lane;
#pragma unroll
    for (int j = 0; j < 4; ++j) { u32x2 w; w.x = cvtpk(v[j][0], v[j][1]); w.y = cvtpk(v[j][2], v[j][3]); o[64 * j] = w; }
    if (lane == 0) rs[row] = rsqrtf(s * (1.f / DM) + EPS);
}
__device__ __forceinline__ void row_final(const float* __restrict__ xrow, const bf16_t* __restrict__ yrow, const float* __restrict__ ssp, const float* __restrict__ gpost, float* orow, bf16_t* xbrow, float* rs, int row, int lane) {
    const float ssv = wave_sum(lane < 32 ? ssp[lane] : 0.f);
    const float rn = rsqrtf(ssv * (1.f / DM) + EPS);
    const f32x4* xr = (const f32x4*)xrow + lane; const u32x2* yr = (const u32x2*)yrow + lane; const f32x4* gr = (const f32x4*)gpost + lane;
    f32x4 v[4]; float s = 0.f;
#pragma unroll
    for (int j = 0; j < 4; ++j) { const f32x4 x = xr[64 * j], g = gr[64 * j]; const u32x2 y = yr[64 * j];
        const f32x4 yf = {bflo(y.x), bfhi(y.x), bflo(y.y), bfhi(y.y)};
        v[j] = x + yf * rn * g; s += (v[j][0] * v[j][0] + v[j][1] * v[j][1]) + (v[j][2] * v[j][2] + v[j][3] * v[j][3]); }
    s = wave_sum(s);
    f32x4* oo = (f32x4*)orow + lane; u32x2* o = (u32x2*)xbrow + lane;
#pragma unroll
    for (int j = 0; j < 4; ++j) { oo[64 * j] = v[j]; u32x2 w; w.x = cvtpk(v[j][0], v[j][1]); w.y = cvtpk(v[j][2], v[j][3]); o[64 * j] = w; }
    if (lane == 0) rs[row] = rsqrtf(s * (1.f / DM) + EPS);
}

template <int NR, bool XBF, bool WOUT, bool WXB = true>
__device__ __forceinline__ void rows_final(const float* xp, const float* xs, const bf16_t* __restrict__ Y, const float* __restrict__ ss, const float* __restrict__ gpost, float* out, bf16_t* xb, float* rs, int row0, int lane) {
    f32x4 v[NR][4]; u32x2 yy[NR][4]; float ssl[NR];
#pragma unroll
    for (int r = 0; r < NR; ++r) { const int row = row0 + r;
        const float* xrow = (row < NP_TOK) ? xp + (size_t)row * DM : xs + (size_t)(row - NP_TOK) * DM;
        ssl[r] = (lane < 32) ? ss[(size_t)row * 32 + lane] : 0.f;
#pragma unroll
        for (int j = 0; j < 4; ++j) {
            if (XBF) { const u32x2 xw = *((const u32x2*)(xb + (size_t)row * DM) + lane + 64 * j); v[r][j] = (f32x4){bflo(xw.x), bfhi(xw.x), bflo(xw.y), bfhi(xw.y)}; }
            else v[r][j] = *((const f32x4*)xrow + lane + 64 * j);
            yy[r][j] = *((const u32x2*)(Y + (size_t)row * DM) + lane + 64 * j); } }
    f32x4 g[4];
#pragma unroll
    for (int j = 0; j < 4; ++j) g[j] = *((const f32x4*)gpost + lane + 64 * j);
#pragma unroll
    for (int r = 0; r < NR; ++r) { const int row = row0 + r;
        const float rn = rsqrtf(wave_sum(ssl[r]) * (1.f / DM) + EPS); float s = 0.f;
#pragma unroll
        for (int j = 0; j < 4; ++j) { const f32x4 yf = {bflo(yy[r][j].x), bfhi(yy[r][j].x), bflo(yy[r][j].y), bfhi(yy[r][j].y)};
            v[r][j] = v[r][j] + yf * rn * g[j]; s += (v[r][j][0] * v[r][j][0] + v[r][j][1] * v[r][j][1]) + (v[r][j][2] * v[r][j][2] + v[r][j][3] * v[r][j][3]); }
        s = wave_sum(s);
        f32x4* oo = (f32x4*)(out + (size_t)row * DM) + lane; u32x2* o = (u32x2*)(xb + (size_t)row * DM) + lane;
#pragma unroll
        for (int j = 0; j < 4; ++j) { if (WOUT) oo[64 * j] = v[r][j]; if (WXB) { u32x2 w; w.x = cvtpk(v[r][j][0], v[r][j][1]); w.y = cvtpk(v[r][j][2], v[r][j][3]); o[64 * j] = w; } }
        if (WXB && lane == 0) rs[row] = rsqrtf(s * (1.f / DM) + EPS); }
}
template <int NR>
__device__ __forceinline__ void rows_prep(const float* xp, const float* xs, bf16_t* xb, float* rs, int row0, int lane) {
    f32x4 v[NR][4];
#pragma unroll
    for (int r = 0; r < NR; ++r) { const int row = row0 + r;
        const float* xrow = (row < NP_TOK) ? xp + (size_t)row * DM : xs + (size_t)(row - NP_TOK) * DM;
#pragma unroll
        for (int j = 0; j < 4; ++j) v[r][j] = *((const f32x4*)xrow + lane + 64 * j); }
#pragma unroll
    for (int r = 0; r < NR; ++r) { const int row = row0 + r; float s = 0.f;
#pragma unroll
        for (int j = 0; j < 4; ++j) s += (v[r][j][0] * v[r][j][0] + v[r][j][1] * v[r][j][1]) + (v[r][j][2] * v[r][j][2] + v[r][j][3] * v[r][j][3]);
        s = wave_sum(s);
        u32x2* o = (u32x2*)(xb + (size_t)row * DM) + lane;
#pragma unroll
        for (int j = 0; j < 4; ++j) { u32x2 w; w.x = cvtpk(v[r][j][0], v[r][j][1]); w.y = cvtpk(v[r][j][2], v[r][j][3]); o[64 * j] = w; }
        if (lane == 0) rs[row] = rsqrtf(s * (1.f / DM) + EPS); }
}

constexpr int PH_PER_LAYER = 8, N_PHASES = 1 + DEPTH * PH_PER_LAYER;

__global__ void __launch_bounds__(512, 2) mk_fwd(Params p) {
    extern __shared__ __attribute__((aligned(16))) unsigned char lds_raw[];
    LAS unsigned char* lds = (LAS unsigned char*)lds_raw;
    cg::grid_group grid = cg::this_grid();
    const int G = gridDim.x, bid = blockIdx.x;
    volatile LAS unsigned* bst = (volatile LAS unsigned*)(lds + LDS_BYTES - 16);
    if (threadIdx.x < 4) bst[threadIdx.x] = 0u;
    __syncthreads();
    (void)xcd_barrier_post((unsigned*)(p.ws + WS_BAR), bst);
#define XBAR() do { XcdBarrier b_; { unsigned char* w_ = p.ws; asm volatile("" : "+s"(w_)); b_.bar = (unsigned*)(w_ + WS_BAR); } b_.x = xb_xcc_id(); b_.st = (volatile LAS unsigned*)(lds + LDS_BYTES - 16); xcd_barrier(b_); } while (0)
#define TIDS int tid = threadIdx.x; asm volatile("" : "+v"(tid)); const int lane = tid & 63, wave = __builtin_amdgcn_readfirstlane(tid >> 6); const int gw = bid * 8 + wave, NGW = G * 8; (void)lane; (void)gw; (void)NGW;
#define WSPTRS \
    unsigned char* ws = p.ws; asm volatile("" : "+s"(ws)); \
    bf16_t* U = (bf16_t*)(ws + WS_U); bf16_t* OCV = (bf16_t*)(ws + WS_OCV); bf16_t* XB = (bf16_t*)(ws + WS_XB); bf16_t* WB = (bf16_t*)(ws + WS_W); \
    float* RSA = (float*)(ws + WS_RSA); float* RSB = (float*)(ws + WS_RSB); float* SS = (float*)(ws + WS_SS); \
    bf16_t* MERGED = (bf16_t*)(ws + WS_MERGED); bf16_t* Y1 = (bf16_t*)(ws + WS_Y1); u32x4* GSCR = (u32x4*)(ws + WS_GSCR); bf16_t* HID = (bf16_t*)(ws + WS_HID); bf16_t* Y2 = (bf16_t*)(ws + WS_Y2); \
    const bf16_t* wl = WB + (size_t)l * W_LAYER; (void)U; (void)OCV; (void)XB; (void)RSA; (void)RSB; (void)SS; (void)MERGED; (void)Y1; (void)GSCR; (void)HID; (void)Y2; (void)wl;
#if MK_SPLIT
    const int lo = p.ph_lo, hi = p.ph_hi;
#define IN(k) (lo <= (k) && (k) < hi)
#define SEAM(k) do { if (IN(k) && IN((k) + 1)) grid.sync(); } while (0)
#else
#define IN(k) true
#define SEAM(k) do { if ((k) == 0) grid.sync(); else XBAR(); } while (0)
#endif

    if (IN(0)) {
        const int l = 0; WSPTRS (void)l; TIDS
        LAS float* scr = (LAS float*)(lds + wave * 16384);
        constexpr int I_MIX = 16 * (MIXC / 32), I_GATE = 16 * (GATEC / 32), I_BR = 8 * (DM / 32), I_OUT = 16 * (DM / 32), I_F1 = 16 * (FF2 / 32), I_F2 = (FFH / 64) * (DM / 32);
        constexpr int I_LAYER = I_MIX + I_GATE + 3 * I_BR + I_OUT + I_F1 + I_F2;
        for (int it = gw; it < DEPTH * I_LAYER; it += NGW) {
            const int l2 = it / I_LAYER; int r = it % I_LAYER; bf16_t* wl2 = WB + (size_t)l2 * W_LAYER;
            const float* win = p.in[I_WIN] + (size_t)l2 * DM * IN_COLS;
            if (r < I_MIX) { wprep_item(win, IN_COLS, DM, wl2 + W_MIX, MIXC / 32, r, 2, 0, p.in[I_LMPRE] + l2 * DM, scr, lane); continue; } r -= I_MIX;
            if (r < I_GATE) { wprep_item(win, IN_COLS, DM, wl2 + W_GATE, GATEC / 32, r, 0, MIXC, p.in[I_LMPRE] + l2 * DM, scr, lane); continue; } r -= I_GATE;
            if (r < 3 * I_BR) { const int b = r / I_BR; wprep_item(p.in[I_WBR] + (size_t)(l2 * 3 + b) * 512 * DM, DM, 512, wl2 + W_BR + (size_t)b * DM * 512, DM / 32, r % I_BR, 0, 0, nullptr, scr, lane); continue; } r -= 3 * I_BR;
            if (r < I_OUT) { wprep_item(p.in[I_WOUT] + (size_t)l2 * DM * DM, DM, DM, wl2 + W_OUT, DM / 32, r, 0, 0, nullptr, scr, lane); continue; } r -= I_OUT;
            if (r < I_F1) { wprep_item(p.in[I_WF1] + (size_t)l2 * DM * FF2, FF2, DM, wl2 + W_F1, FF2 / 32, r, 1, 0, p.in[I_LFPRE] + l2 * DM, scr, lane); continue; } r -= I_F1;
            wprep_item(p.in[I_WF2] + (size_t)l2 * FFH * DM, DM, FFH, wl2 + W_F2, DM / 32, r, 0, 0, nullptr, scr, lane);
        }
        for (int m = gw * 4; m < T_TOK; m += NGW * 4) rows_prep<4>(p.in[I_XP], p.in[I_XS], XB, RSA, m, lane);
    }
    SEAM(0);

    for (int l = 0; l < DEPTH; ++l) {
        const int pb = 1 + l * PH_PER_LAYER;
        const float lam_init = 0.8f - 0.6f * expf(-0.3f * (float)l);
        if (IN(pb + 0)) { WSPTRS
#ifndef NO_G1
            PREP {
            pg8::Gemm g{XB, wl + W_MIX, T_TOK, MIXC, DM}; pg8::StaticOrder S; S.init(T_TOK, MIXC, G, bid);
            pg8::EpiMix E{U, RSA};
            pg8::gemm_phase<pg8::EpiMix, pg8::StaticOrder, true, true>(lds, g, S, E);
            }
#endif
        }
        SEAM(pb + 0);
        if (IN(pb + 1)) { WSPTRS TIDS
            LAS float* tabf = (LAS float*)(lds + LDS_TAB);
            for (int i = tid; i < 4 * 257; i += 512) { const int hd = i / 257, j = i % 257; tabf[i] = p.in[I_T5][t5_bucket(j - 128) * 4 + hd] * LOG2E; }
            if (wave == 0) { const float* lm = p.in[I_LAM] + l * 256;
                const float a = wave_sum(lm[lane] * lm[64 + lane]), b = wave_sum(lm[128 + lane] * lm[192 + lane]);
                if (lane == 0) tabf[4 * 257] = expf(a) - expf(b) + lam_init; }
            __syncthreads();
            const float lam = tabf[4 * 257];
            const float* subg = p.in[I_SUBG] + l * 128;
            bf16_t* DQ = U + S_DQ * SEC_ELEMS; const bf16_t* DK = U + S_DK * SEC_ELEMS; const bf16_t* DV = U + S_DV * SEC_ELEMS;
#ifndef NO_DIFF
#ifdef PROBE_DIFF
            for (int rep = 0; rep < 2; ++rep)
#else
            const int rep = 1;
#endif
            for (int uu = bid; uu < 2560; uu += G) {
                const int rnd = uu >> 8, idx = uu & 255, xcd = idx & 7, slot = idx >> 3; long R0; int S, hd, qb;
                if (rnd < 8) { const int pair = rnd * 16 + xcd * 2 + (slot >> 4); R0 = (long)(pair >> 2) * SEQ_P; S = SEQ_P; hd = pair & 3; qb = slot & 15; }
                else { const int pair = (rnd - 8) * 4 + (xcd >> 1); R0 = (long)NP_TOK + (long)(pair >> 2) * SEQ_S; S = SEQ_S; hd = pair & 3; qb = (xcd & 1) * 32 + slot; }
                diff_unit(lds, DK, DV, DQ, R0, S, hd, qb, lam, 1.f - lam_init, subg, rep == 0);
            }
#endif
#ifndef NO_NA
            __syncthreads();
            for (int i = tid; i < 8 * 465; i += 512) tabf[i] = p.in[I_RPB][l * 3720 + i] * LOG2E;
            __syncthreads();
            bf16_t* NAQ = U + S_NAQ * SEC_ELEMS; const bf16_t* NAK = U + S_NAK * SEC_ELEMS; const bf16_t* NAV = U + S_NAV * SEC_ELEMS;
#ifdef PROBE_NA
            for (int rep2 = 0; rep2 < 2; ++rep2)
#else
            const int rep2 = 1;
#endif
            for (int uraw = bid; uraw < 4 * (T_TOK / 128); uraw += G) {
                const int uidx = (uraw & ~255) + (uraw & 7) * 32 + ((uraw >> 3) & 31); const int hpair = uidx & 3, gp = uidx >> 2;
                long R0; int rows, r0;
                if (gp < NP_TOK / 128) { const int b = gp / (SEQ_P / 128); r0 = 2 * (gp % (SEQ_P / 128)); rows = SEQ_P / 64; R0 = (long)b * SEQ_P; }
                else { const int g2 = gp - NP_TOK / 128; const int b = g2 / (SEQ_S / 128); r0 = 2 * (g2 % (SEQ_S / 128)); rows = SEQ_S / 64; R0 = (long)NP_TOK + (long)b * SEQ_S; }
                na_unit(lds, NAK, NAV, NAQ, R0, rows, r0, hpair, rep2 == 0); }
#endif
#ifndef NO_CONV
            const bf16_t* CA = U + S_CA * SEC_ELEMS; const bf16_t* CGp = U + S_CG * SEC_ELEMS;
#define CONV_DECODE(u_, R0_, S_, t0_) do { const int tg_ = (u_) * 32; if (tg_ < NP_TOK) { R0_ = (long)(tg_ / SEQ_P) * SEQ_P; S_ = SEQ_P; t0_ = tg_ % SEQ_P; } \
                else { const int t2_ = tg_ - NP_TOK; R0_ = (long)NP_TOK + (long)(t2_ / SEQ_S) * SEQ_S; S_ = SEQ_S; t0_ = t2_ % SEQ_S; } } while (0)
            int ctid = threadIdx.x; asm volatile("" : "+v"(ctid));
            f32x2 cw[31]; f32x4 clnp[4];
            { const float* dww = p.in[I_DWW] + l * 31 * 512; const int cp = ctid & 255, cl = ctid & 63;
#pragma unroll
              for (int k = 0; k < 31; ++k) cw[k] = *(const f32x2*)(dww + k * 512 + 2 * cp);
              clnp[0] = *(const f32x4*)(p.in[I_CLG] + l * 512 + 8 * cl); clnp[1] = *(const f32x4*)(p.in[I_CLG] + l * 512 + 8 * cl + 4);
              clnp[2] = *(const f32x4*)(p.in[I_CLB] + l * 512 + 8 * cl); clnp[3] = *(const f32x4*)(p.in[I_CLB] + l * 512 + 8 * cl + 4); }
            const f32x2 cbv = *(const f32x2*)(p.in[I_DWB] + l * 512 + 2 * (ctid & 255));
            { long cR0 = 0, nR0 = 0; int cS = 0, ct0 = 0, nS = 0, nt0 = 0; bool pre = false; int uidx = bid;
              if (uidx < T_TOK / 32) CONV_DECODE(uidx, cR0, cS, ct0);
              while (uidx < T_TOK / 32) { const int nu = uidx + G; const bool hn = nu < T_TOK / 32; if (hn) CONV_DECODE(nu, nR0, nS, nt0);
                  conv_unit(lds, CA, CGp, OCV, cw, cbv, clnp, ctid, cR0, cS, ct0, pre, hn, nR0, nS, nt0);
                  pre = hn; cR0 = nR0; cS = nS; ct0 = nt0; uidx = nu; } }
#undef CONV_DECODE
#endif
        }
        SEAM(pb + 1);
        if (IN(pb + 2)) { WSPTRS
#ifndef NO_G3
            PREP {
            u32x4* G01 = (u32x4*)p.out;
            { pg8::Gemm g{XB, wl + W_GATE, T_TOK, GATEC, DM}; pg8::StaticOrder S3; S3.init(T_TOK, GATEC, G, bid);
              pg8::EpiGate E{G01, GSCR, RSA, p.in[I_BGATE] + l * GATEC};
              pg8::gemm_phase<pg8::EpiGate, pg8::StaticOrder, true, true>(lds, g, S3, E); }
            { pg8::Grouped3Order S; S.so.init(T_TOK, DM, G, bid); S.a1 = (size_t)(WS_OCV - WS_U); S.a2 = (size_t)S_DQ * SEC_BYTES; S.bstep = (size_t)DM * 512 * 2;
              pg8::Gemm g{U, wl + W_BR, T_TOK, DM, 512}; pg8::EpiProj E{G01, GSCR, MERGED};
              pg8::gemm_phase<pg8::EpiProj, pg8::Grouped3Order, true, true>(lds, g, S, E); }
            }
#endif
        }
        SEAM(pb + 2);
        if (IN(pb + 3)) { WSPTRS
#ifndef NO_G4
            PREP {
            pg8::Gemm g{MERGED, wl + W_OUT, T_TOK, DM, DM}; pg8::StaticOrder S; S.init(T_TOK, DM, G, bid);
            pg8::EpiY E{Y1, SS + (size_t)(2 * l) * T_TOK * 32};
            pg8::gemm_phase<pg8::EpiY, pg8::StaticOrder, true, true>(lds, g, S, E);
            }
#endif
        }
        SEAM(pb + 3);
        if (IN(pb + 4)) { WSPTRS TIDS
            if (l == 0) { for (int m = gw * 4; m < T_TOK; m += NGW * 4) rows_final<4, false, false>(p.in[I_XP], p.in[I_XS], Y1, SS + (size_t)(2 * l) * T_TOK * 32, p.in[I_LMPOST] + l * DM, p.out, XB, RSB, m, lane); }
            else { for (int m = gw * 4; m < T_TOK; m += NGW * 4) rows_final<4, true, false>(nullptr, nullptr, Y1, SS + (size_t)(2 * l) * T_TOK * 32, p.in[I_LMPOST] + l * DM, p.out, XB, RSB, m, lane); }
        }
        SEAM(pb + 4);
        if (IN(pb + 5)) { WSPTRS
#ifndef NO_G6
            PREP {
            pg8::Gemm g{XB, wl + W_F1, T_TOK, FF2, DM}; pg8::StaticOrder S; S.init(T_TOK, FF2, G, bid);
            pg8::EpiFfn E{HID, RSB};
            pg8::gemm_phase<pg8::EpiFfn, pg8::StaticOrder, true, true>(lds, g, S, E);
            }
#endif
        }
        SEAM(pb + 5);
        if (IN(pb + 6)) { WSPTRS
#ifndef NO_G7
            PREP {
            pg8::Gemm g{HID, wl + W_F2, T_TOK, DM, FFH}; pg8::StaticOrder S; S.init(T_TOK, DM, G, bid);
            pg8::EpiY E{Y2, SS + (size_t)(2 * l + 1) * T_TOK * 32};
            pg8::gemm_phase<pg8::EpiY, pg8::StaticOrder, true, true>(lds, g, S, E);
            }
#endif
        }
        SEAM(pb + 6);
        if (IN(pb + 7)) { WSPTRS TIDS
            if (l + 1 < DEPTH) { for (int m = gw * 4; m < T_TOK; m += NGW * 4) rows_final<4, true, false>(nullptr, nullptr, Y2, SS + (size_t)(2 * l + 1) * T_TOK * 32, p.in[I_LFPOST] + l * DM, p.out, XB, RSA, m, lane); }
            else { for (int m = gw * 4; m < T_TOK; m += NGW * 4) rows_final<4, true, true, false>(nullptr, nullptr, Y2, SS + (size_t)(2 * l + 1) * T_TOK * 32, p.in[I_LFPOST] + l * DM, p.out, XB, RSA, m, lane); }
        }
        if (l + 1 < DEPTH) { SEAM(pb + 7); }
    }
#undef IN
#undef SEAM
}

extern "C" void kernel_launch(void* const* d_in, const int* in_sizes, int n_in, void* d_out, int out_size, void* d_ws, size_t ws_size, hipStream_t stream) {
    static int grid = 0;
    if (grid == 0) {
        if (n_in != 20 || ws_size < WS_END) { fprintf(stderr, "kernel_launch: unexpected n_in %d / ws_size %zu (need %zu)\n", n_in, ws_size, (size_t)WS_END); grid = -1; return; }
        int dev = 0, cus = 0, per_cu = 0;
        hipGetDevice(&dev);
        hipDeviceGetAttribute(&cus, hipDeviceAttributeMultiprocessorCount, dev);
        if (hipFuncSetAttribute((const void*)mk_fwd, hipFuncAttributeMaxDynamicSharedMemorySize, LDS_BYTES) != hipSuccess) { fprintf(stderr, "kernel_launch: hipFuncSetAttribute failed\n"); grid = -1; return; }
        if (hipOccupancyMaxActiveBlocksPerMultiprocessor(&per_cu, (const void*)mk_fwd, 512, LDS_BYTES) != hipSuccess || per_cu < 1) { fprintf(stderr, "kernel_launch: occupancy query gave %d\n", per_cu); per_cu = 1; }
        (void)hipGetLastError();
        grid = cus * per_cu;
        if (grid > 256) grid = 256;
    }
    if (grid < 0) return;
    Params p{};
    for (int i = 0; i < 20; ++i) p.in[i] = (const float*)d_in[i];
    p.out = (float*)d_out; p.ws = (unsigned char*)d_ws;
#if MK_SPLIT
    for (int ph = 0; ph < N_PHASES; ++ph) {
        p.ph_lo = ph; p.ph_hi = ph + 1;
        hipLaunchKernelGGL(mk_fwd, dim3(grid), dim3(512), LDS_BYTES, stream, p);
    }
#else
    p.ph_lo = 0; p.ph_hi = N_PHASES;
    (void)hipMemsetAsync((char*)d_ws + WS_BAR, 0, BAR_BYTES, stream);
    void* args[] = {&p};
    hipError_t e = hipLaunchCooperativeKernel((const void*)mk_fwd, dim3(grid), dim3(512), args, LDS_BYTES, stream);
    if (e != hipSuccess) fprintf(stderr, "cooperative launch failed: %s (grid %d)\n", hipGetErrorString(e), grid);
#endif
}
```

```cpp
#include <hip/hip_runtime.h>
#include <hip/hip_cooperative_groups.h>
#include <cstdio>
#include <cstdint>
namespace cg = cooperative_groups;

#ifdef PROBE_GEMM
#define PREP for (int rep9 = 0; rep9 < 2; ++rep9)
#else
#define PREP
#endif
#ifndef MK_SPLIT
#define MK_SPLIT 0
#endif

#define LAS __attribute__((address_space(3)))
typedef unsigned short bf16_t;
typedef short bf16x8 __attribute__((ext_vector_type(8)));
typedef short s16x4 __attribute__((ext_vector_type(4)));
typedef float f32x4 __attribute__((ext_vector_type(4)));
typedef float f32x2 __attribute__((ext_vector_type(2)));
typedef float f32x16 __attribute__((ext_vector_type(16)));
typedef unsigned u32x4 __attribute__((ext_vector_type(4)));
typedef unsigned u32x2 __attribute__((ext_vector_type(2)));
typedef __bf16 bf16x2_t __attribute__((ext_vector_type(2)));

constexpr int T_TOK = 81920, NP_TOK = 65536, DM = 1024;
constexpr int SEQ_P = 2048, SEQ_S = 8192;
constexpr int IN_COLS = 7168, MIXC = 4096, GATEC = 3072, FFH = 2816, FF2 = 5632;
constexpr int DEPTH = 2;
constexpr float EPS = 1e-6f;
constexpr float LOG2E = 1.4426950408889634f;
constexpr float QSCALE = 0.125f * LOG2E;

constexpr size_t MiB = 1u << 20;
constexpr size_t SEC_ELEMS = (size_t)T_TOK * 512;
constexpr size_t SEC_BYTES = SEC_ELEMS * 2;
enum { S_NAQ = 0, S_NAK = 1, S_NAV = 2, S_CA = 3, S_CG = 4, S_DQ = 5, S_DK = 6, S_DV = 7 };
constexpr size_t WS_U = 0;
constexpr size_t WS_OCV = 8 * SEC_BYTES;
constexpr size_t WS_XB = 9 * SEC_BYTES;
constexpr size_t WS_W = 11 * SEC_BYTES;
constexpr size_t W_MIX = 0, W_GATE = W_MIX + (size_t)MIXC * DM, W_BR = W_GATE + (size_t)GATEC * DM, W_OUT = W_BR + (size_t)3 * DM * 512,
                 W_F1 = W_OUT + (size_t)DM * DM, W_F2 = W_F1 + (size_t)FF2 * DM, W_LAYER = W_F2 + (size_t)DM * FFH;
constexpr size_t WS_SMALL = WS_W + ((2 * W_LAYER * 2 + MiB - 1) / MiB) * MiB;
constexpr size_t RS_BYTES = (size_t)T_TOK * 4;
constexpr size_t WS_RSA = WS_SMALL, WS_RSB = WS_RSA + RS_BYTES, WS_SS = WS_RSB + RS_BYTES;
constexpr size_t WS_BAR = WS_SS + 4 * 32 * RS_BYTES;
constexpr size_t BAR_BYTES = 16384;
constexpr size_t WS_END = WS_BAR + BAR_BYTES;
constexpr size_t WS_MERGED = 1 * SEC_BYTES;
constexpr size_t WS_Y1 = 3 * SEC_BYTES;
constexpr size_t WS_GSCR = 6 * SEC_BYTES;
constexpr size_t WS_HID = 0;
constexpr size_t WS_Y2 = 6 * SEC_BYTES;
static_assert((size_t)T_TOK * FFH * 2 <= 6 * SEC_BYTES, "hidden overlay");

constexpr int LDS_BYTES = 147456;
constexpr int LDS_TAB = 131072;

__device__ __forceinline__ unsigned cvtpk(float lo, float hi) { f32x2 v = {lo, hi}; bf16x2_t b = __builtin_convertvector(v, bf16x2_t); return __builtin_bit_cast(unsigned, b); }
__device__ __forceinline__ float bflo(unsigned u) { return __uint_as_float(u << 16); }
__device__ __forceinline__ float bfhi(unsigned u) { return __uint_as_float(u & 0xffff0000u); }
__device__ __forceinline__ float wave_sum(float v) {
#pragma unroll
    for (int o = 1; o < 64; o <<= 1) v += __shfl_xor(v, o);
    return v;
}
__device__ __forceinline__ float sigmoidf_(float x) { return __builtin_amdgcn_rcpf(1.f + __expf(-x)); }

namespace gm {
constexpr int TM = 256, TN = 128, BK = 64, A_STAGE = TM * BK * 2, B_STAGE = TN * BK * 2, STAGE = A_STAGE + B_STAGE;
__device__ __forceinline__ unsigned sw(unsigned r, unsigned c) { return r * 128u + ((c ^ ((r >> 1) & 7u)) << 4); }
typedef f32x4 Acc[4][4];
template <class Epi>
__device__ __forceinline__ void gemm_unit(LAS unsigned char* lds, const bf16_t* __restrict__ A, const bf16_t* __restrict__ Bt, int K, const Epi& E, int pm, int pn) {
    int tid = threadIdx.x; asm volatile("" : "+v"(tid));
    const int lane = tid & 63, wid = __builtin_amdgcn_readfirstlane(tid >> 6), wm = wid >> 1, wn = wid & 1, fr = lane & 15, fq = lane >> 4;
    const int r0 = tid >> 3, c0 = tid & 7;
    const bf16_t* ga = A + (size_t)(pm * TM + r0) * K + c0 * 8;
    const bf16_t* gb = Bt + (size_t)(pn * TN + r0) * K + c0 * 8;
    const size_t rstep = (size_t)64 * K;
    const unsigned lw = sw(r0, c0);
    const unsigned ra = sw(wm * 64 + fr, fq), rb = sw(wn * 64 + fr, fq);
    Acc acc;
#pragma unroll
    for (int m = 0; m < 4; ++m)
#pragma unroll
        for (int n = 0; n < 4; ++n) acc[m][n] = (f32x4){0.f, 0.f, 0.f, 0.f};
    u32x4 pa[4], pb[2];
#pragma unroll
    for (int i = 0; i < 4; ++i) pa[i] = *(const u32x4*)(ga + i * rstep);
#pragma unroll
    for (int i = 0; i < 2; ++i) pb[i] = *(const u32x4*)(gb + i * rstep);
#pragma unroll
    for (int i = 0; i < 4; ++i) *(LAS u32x4*)(lds + lw + i * 8192) = pa[i];
#pragma unroll
    for (int i = 0; i < 2; ++i) *(LAS u32x4*)(lds + A_STAGE + lw + i * 8192) = pb[i];
    __syncthreads();
    const int nk = K / BK;
    for (int kt = 0; kt < nk; ++kt) {
        const LAS unsigned char* Ab = lds + (kt & 1) * STAGE; const LAS unsigned char* Bb = Ab + A_STAGE;
        if (kt + 1 < nk) {
#pragma unroll
            for (int i = 0; i < 4; ++i) pa[i] = *(const u32x4*)(ga + (size_t)(kt + 1) * BK + i * rstep);
#pragma unroll
            for (int i = 0; i < 2; ++i) pb[i] = *(const u32x4*)(gb + (size_t)(kt + 1) * BK + i * rstep);
        }
#pragma unroll
        for (int kk = 0; kk < 2; ++kk) {
            bf16x8 af[4], bfr[4];
#pragma unroll
            for (int m = 0; m < 4; ++m) af[m] = *(const LAS bf16x8*)(Ab + ((ra + m * 2048) ^ (kk * 64)));
#pragma unroll
            for (int n = 0; n < 4; ++n) bfr[n] = *(const LAS bf16x8*)(Bb + ((rb + n * 2048) ^ (kk * 64)));
#pragma unroll
            for (int m = 0; m < 4; ++m)
#pragma unroll
                for (int n = 0; n < 4; ++n) acc[m][n] = __builtin_amdgcn_mfma_f32_16x16x32_bf16(bfr[n], af[m], acc[m][n], 0, 0, 0);
        }
        if (kt + 1 < nk) { LAS unsigned char* nb = lds + ((kt + 1) & 1) * STAGE;
#pragma unroll
            for (int i = 0; i < 4; ++i) *(LAS u32x4*)(nb + lw + i * 8192) = pa[i];
#pragma unroll
            for (int i = 0; i < 2; ++i) *(LAS u32x4*)(nb + A_STAGE + lw + i * 8192) = pb[i];
        }
        __syncthreads();
    }
    E(acc, pm * TM + wm * 64, pn * TN + wn * 64, fr, fq);
}

__device__ __forceinline__ u32x2 pack4(f32x4 v) { u32x2 w; w.x = cvtpk(v[0], v[1]); w.y = cvtpk(v[2], v[3]); return w; }
__device__ __forceinline__ f32x4 unpack4(u32x2 w) { return (f32x4){bflo(w.x), bfhi(w.x), bflo(w.y), bfhi(w.y)}; }

struct EpiMix {
    bf16_t* U; const float* rs;
    __device__ __forceinline__ void operator()(const Acc& acc, int row0, int col0, int fr, int fq) const {
        const int sec = col0 >> 9; bf16_t* base = U + (size_t)sec * SEC_ELEMS + (col0 & 511) + 4 * fq; const float sc = (sec == S_NAQ || sec == S_DQ) ? QSCALE : 1.f;
#pragma unroll
        for (int m = 0; m < 4; ++m) { const int row = row0 + m * 16 + fr; const float r = rs[row] * sc; bf16_t* rowp = base + (size_t)row * 512;
#pragma unroll
            for (int n = 0; n < 4; ++n) *(u32x2*)(rowp + n * 16) = pack4(acc[m][n] * r); }
    }
};
struct EpiGate {
    u32x2* gscr; const float* rs; const float* bias;
    __device__ __forceinline__ void operator()(const Acc& acc, int row0, int col0, int fr, int fq) const {
        u32x2* slot = gscr + threadIdx.x;
        f32x4 bv[4];
#pragma unroll
        for (int n = 0; n < 4; ++n) bv[n] = *(const f32x4*)(bias + col0 + n * 16 + 4 * fq);
#pragma unroll
        for (int m = 0; m < 4; ++m) { const float r = rs[row0 + m * 16 + fr];
#pragma unroll
            for (int n = 0; n < 4; ++n) { f32x4 v = acc[m][n] * r + bv[n];
#pragma unroll
                for (int j = 0; j < 4; ++j) v[j] = sigmoidf_(v[j]);
                slot[(m * 4 + n) * 512] = pack4(v); } }
    }
};
struct EpiProj {
    const u32x2* gscr; bf16_t* merged; int first;
    __device__ __forceinline__ void operator()(const Acc& acc, int row0, int col0, int fr, int fq) const {
        const u32x2* slot = gscr + threadIdx.x;
#pragma unroll
        for (int m = 0; m < 4; ++m) { bf16_t* rowp = merged + (size_t)(row0 + m * 16 + fr) * DM + col0 + 4 * fq;
#pragma unroll
            for (int n = 0; n < 4; ++n) { f32x4 v = unpack4(slot[(m * 4 + n) * 512]) * acc[m][n];
                if (!first) v += unpack4(*(const u32x2*)(rowp + n * 16));
                *(u32x2*)(rowp + n * 16) = pack4(v); } }
    }
};
struct EpiY {
    bf16_t* Y; float* ss;
    __device__ __forceinline__ void operator()(const Acc& acc, int row0, int col0, int fr, int fq) const {
#pragma unroll
        for (int m = 0; m < 4; ++m) { const int row = row0 + m * 16 + fr; bf16_t* rowp = Y + (size_t)row * DM + col0 + 4 * fq; float s = 0.f;
#pragma unroll
            for (int n = 0; n < 4; ++n) { const f32x4 v = acc[m][n]; s += (v[0] * v[0] + v[1] * v[1]) + (v[2] * v[2] + v[3] * v[3]); *(u32x2*)(rowp + n * 16) = pack4(v); }
            s += __shfl_xor(s, 16); s += __shfl_xor(s, 32);
            if (fq == 0) ss[(size_t)row * 16 + (col0 >> 6)] = s; }
    }
};
struct EpiFfn {
    bf16_t* H; const float* rs;
    __device__ __forceinline__ void operator()(const Acc& acc, int row0, int col0, int fr, int fq) const {
#pragma unroll
        for (int m = 0; m < 4; ++m) { const int row = row0 + m * 16 + fr; const float r = rs[row]; bf16_t* rowp = H + (size_t)row * FFH + (col0 >> 1) + 4 * fq;
#pragma unroll
            for (int i = 0; i < 2; ++i) { const f32x4 gv = acc[m][2 * i] * r, uv = acc[m][2 * i + 1] * r; f32x4 h;
#pragma unroll
                for (int j = 0; j < 4; ++j) h[j] = gv[j] * sigmoidf_(gv[j]) * uv[j];
                *(u32x2*)(rowp + i * 16) = pack4(h); } }
    }
};
}

namespace pg8 {
constexpr int BM = 256, BK = 64, HALF = 128, HTB = HALF * BK * 2  , STAGE_BYTES = 8 * HTB, NXCD = 8, WGM = 8;

__host__ __device__ __forceinline__ int lds_byte(int r, int c) { const int st = (r >> 4) * 2 + (c >> 5), rr = r & 15, cc = c & 31, ob = rr * 64 + cc * 2; return st * 1024 + (ob ^ (((ob >> 9) & 1) << 5)); }
__host__ __device__ __forceinline__ void stage_rc(int b, int& R, int& C) { const int st = b / 1024, sb = b % 1024, swz = sb ^ (((sb >> 9) & 1) << 5); R = (st >> 1) * 16 + swz / 64; C = (st & 1) * 32 + (swz % 64) / 2; }
__host__ __device__ __forceinline__ int perm32(int rho) { const int n = rho >> 4, i = rho & 15; return 8 * (i >> 2) + 4 * n + (i & 3); }

struct Unit { int pm, pn, z; };
struct Gemm { const bf16_t* A; const bf16_t* Bt; int M, N, K; };

struct StaticOrder {
    int nM, nN, nwg, G, c;
    __host__ __device__ void init(int M, int N, int G_, int c_) { nM = M / BM; nN = N / BM; nwg = nM * nN; G = G_; c = c_; }
    __host__ __device__ bool next(int i, Unit& u) const {
        const long L = (long)i * G + c; if (L >= nwg) return false;
        int wgid = (int)L; { const int q = nwg / NXCD, r = nwg % NXCD, xcd = wgid % NXCD, off = wgid / NXCD; wgid = (xcd < r ? xcd * (q + 1) : r * (q + 1) + (xcd - r) * q) + off; }
        const int nig = WGM * nN, gid = wgid / nig, fm = gid * WGM, gsz = (nM - fm) < WGM ? (nM - fm) : WGM;
        u.pm = fm + ((wgid % nig) % gsz); u.pn = (wgid % nig) / gsz; u.z = 0; return true;
    }
    __device__ __forceinline__ void a_ready(const Unit&) const {}
    __device__ __forceinline__ void done(const Unit&) const {}
    __device__ __forceinline__ size_t aoff(const Unit&) const { return 0; }
    __device__ __forceinline__ size_t boff(const Unit&) const { return 0; }
};
struct Grouped3Order {
    StaticOrder so; size_t a1, a2, bstep;
    __device__ __forceinline__ bool next(int i, Unit& u) const { const int t = i / 3; if (!so.next(t, u)) return false; u.z = i - 3 * t; return true; }
    __device__ __forceinline__ void a_ready(const Unit&) const {}
    __device__ __forceinline__ void done(const Unit&) const {}
    __device__ __forceinline__ size_t aoff(const Unit& u) const { return u.z == 0 ? 0 : (u.z == 1 ? a1 : a2); }
    __device__ __forceinline__ size_t boff(const Unit& u) const { return (size_t)u.z * bstep; }
};
template <class Epi, class Sched, bool ALIGN_EPI = false, bool SP2 = false>
__device__ __forceinline__ void gemm_phase(LAS unsigned char* lds, const Gemm g, const Sched& S, const Epi& E) {
    int tid = threadIdx.x; asm volatile("" : "+v"(tid));
    const int wid = __builtin_amdgcn_readfirstlane(tid >> 6), lane = tid & 63, wr = wid >> 2, wc = wid & 3, fr = lane & 15, fq = lane >> 4;
    const int K = g.K, nt = K / BK;
    unsigned voffA[2], voffB[2];
#pragma unroll
    for (int i = 0; i < 2; ++i) { int R, C; stage_rc(tid * 16 + i * 8192, R, C); const int Rb = Epi::PERM ? ((R & ~31) + perm32(R & 31)) : R;
        voffA[i] = (unsigned)(R * K + C) * 2u; voffB[i] = (unsigned)(Rb * K + C) * 2u; }
    const size_t kstep = (size_t)(BK * 2);
    const size_t hstep = (size_t)HALF * K * 2;
    const size_t tstep = 2 * hstep;
    const unsigned ldsw = (unsigned)wid * 1024u;
    const int aoff = lds_byte(wr * 64 + fr, fq * 8), boff = lds_byte(wc * 32 + fr, fq * 8);
#define PG8_SA(b, h) (((b) * 2 + (h)) * HTB)
#define PG8_SB(b, h) ((4 + (b) * 2 + (h)) * HTB)
#define PG8_STAGE(bufoff, gbase, voff) do { _Pragma("unroll") for (int _i = 0; _i < 2; ++_i) \
        __builtin_amdgcn_global_load_lds((const unsigned*)((const char*)(gbase) + (voff)[_i]), (LAS unsigned*)(lds + (bufoff) + ldsw + _i * 8192), 16, 0, 0); } while (0)
#define PG8_LDA(dst, b, h) do { _Pragma("unroll") for (int m = 0; m < 4; ++m) _Pragma("unroll") for (int k = 0; k < 2; ++k) dst[m][k] = *(const LAS bf16x8*)(lds + PG8_SA(b, h) + aoff + m * 2048 + k * 1024); } while (0)
#define PG8_LDB(dst, b, h) do { _Pragma("unroll") for (int n = 0; n < 2; ++n) _Pragma("unroll") for (int k = 0; k < 2; ++k) dst[n][k] = *(const LAS bf16x8*)(lds + PG8_SB(b, h) + boff + n * 2048 + k * 1024); } while (0)
#define PG8_MMA(ai, bj, At, Bt) do { __builtin_amdgcn_s_setprio(1); _Pragma("unroll") for (int m = 0; m < 4; ++m) _Pragma("unroll") for (int n = 0; n < 2; ++n) _Pragma("unroll") for (int k = 0; k < 2; ++k) \
        acc[ai][bj][m][n] = __builtin_amdgcn_mfma_f32_16x16x32_bf16(Bt[n][k], At[m][k], acc[ai][bj][m][n], 0, 0, 0); __builtin_amdgcn_s_setprio(0); } while (0)
#define PG8_WAIT_V(n) asm volatile("s_waitcnt vmcnt(" #n ")" ::: "memory")
#define PG8_WAIT_L(n) asm volatile("s_waitcnt lgkmcnt(" #n ")" ::: "memory")
#define PG8_BAR __builtin_amdgcn_s_barrier()
#define PG8_SCHED __builtin_amdgcn_sched_barrier(0)
    Unit cur, nxt; int ui = 0;
    if (!S.next(0, cur)) return;
    f32x4 acc[2][2][4][2];
#pragma unroll
    for (int a = 0; a < 2; ++a)
#pragma unroll
        for (int b = 0; b < 2; ++b)
#pragma unroll
            for (int m = 0; m < 4; ++m)
#pragma unroll
                for (int n = 0; n < 2; ++n) acc[a][b][m][n] = (f32x4){0.f, 0.f, 0.f, 0.f};
    bf16x8 At[4][2], B0[2][2], B1[2][2];
    const char* cA = (const char*)g.A + S.aoff(cur) + (size_t)cur.pm * tstep; const char* cB = (const char*)g.Bt + S.boff(cur) + (size_t)cur.pn * tstep;
    S.a_ready(cur);
    if constexpr (SP2) {
        PG8_STAGE(PG8_SB(0, 0), cB, voffB); PG8_STAGE(PG8_SB(0, 1), cB + hstep, voffB); PG8_STAGE(PG8_SA(0, 0), cA, voffA); PG8_STAGE(PG8_SA(0, 1), cA + hstep, voffA);
        if (wr == 1) PG8_BAR;
        PG8_WAIT_V(2); PG8_BAR;
        PG8_STAGE(PG8_SB(1, 0), cB + kstep, voffB); PG8_STAGE(PG8_SA(1, 0), cA + kstep, voffA); PG8_STAGE(PG8_SB(1, 1), cB + hstep + kstep, voffB);
        PG8_WAIT_V(6); PG8_BAR;
    } else {
        PG8_STAGE(PG8_SB(0, 0), cB, voffB); PG8_STAGE(PG8_SA(0, 0), cA, voffA); PG8_STAGE(PG8_SB(0, 1), cB + hstep, voffB); PG8_STAGE(PG8_SA(0, 1), cA + hstep, voffA);
        if (wr == 1) PG8_BAR;
        PG8_WAIT_V(4); PG8_BAR;
        PG8_STAGE(PG8_SB(1, 0), cB + kstep, voffB); PG8_STAGE(PG8_SA(1, 0), cA + kstep, voffA); PG8_STAGE(PG8_SB(1, 1), cB + hstep + kstep, voffB);
        PG8_WAIT_V(6); PG8_BAR;
    }
    for (;;) {
        const bool has_next = S.next(ui + 1, nxt);
        const char* nA = has_next ? (const char*)g.A + S.aoff(nxt) + (size_t)nxt.pm * tstep : cA; const char* nB = has_next ? (const char*)g.Bt + S.boff(nxt) + (size_t)nxt.pn * tstep : cB;
        for (int t = 0; t < nt; t += 2) {
            const bool last = (t == nt - 2);
            const char* a1 = cA + (size_t)(t + 1) * kstep;
            const char* a2 = last ? nA : cA + (size_t)(t + 2) * kstep; const char* b2 = last ? nB : cB + (size_t)(t + 2) * kstep;
            const char* a3 = a2 + kstep; const char* b3 = b2 + kstep;
            if (last && has_next) S.a_ready(nxt);
            if constexpr (SP2) {
            PG8_LDB(B0, 0, 0); PG8_LDB(B1, 0, 1); PG8_SCHED; PG8_LDA(At, 0, 0); PG8_STAGE(PG8_SA(1, 1), a1 + hstep, voffA);
            PG8_WAIT_V(8); PG8_WAIT_L(0); PG8_BAR; PG8_MMA(0, 0, At, B0); PG8_MMA(0, 1, At, B1); PG8_BAR; PG8_SCHED;
            PG8_LDA(At, 0, 1); PG8_STAGE(PG8_SB(0, 0), b2, voffB); PG8_STAGE(PG8_SB(0, 1), b2 + hstep, voffB); PG8_STAGE(PG8_SA(0, 0), a2, voffA);
            PG8_WAIT_V(8); PG8_WAIT_L(0); PG8_BAR; PG8_MMA(1, 0, At, B0); PG8_MMA(1, 1, At, B1); PG8_BAR; PG8_SCHED;
            PG8_LDB(B0, 1, 0); PG8_LDB(B1, 1, 1); PG8_SCHED; PG8_LDA(At, 1, 0); PG8_STAGE(PG8_SA(0, 1), a2 + hstep, voffA);
            PG8_WAIT_V(8); PG8_WAIT_L(0); PG8_BAR; PG8_MMA(0, 0, At, B0); PG8_MMA(0, 1, At, B1); PG8_BAR; PG8_SCHED;
            PG8_LDA(At, 1, 1); PG8_STAGE(PG8_SB(1, 0), b3, voffB); PG8_STAGE(PG8_SB(1, 1), b3 + hstep, voffB); PG8_STAGE(PG8_SA(1, 0), a3, voffA);
            PG8_WAIT_V(8); PG8_WAIT_L(0); PG8_BAR; PG8_MMA(1, 0, At, B0); PG8_MMA(1, 1, At, B1); PG8_BAR; PG8_SCHED;
            } else {
            PG8_LDB(B0, 0, 0); PG8_SCHED; PG8_LDA(At, 0, 0); PG8_STAGE(PG8_SA(1, 1), a1 + hstep, voffA);
            PG8_WAIT_L(8); PG8_BAR; PG8_WAIT_L(0); PG8_MMA(0, 0, At, B0); PG8_BAR; PG8_SCHED;
            PG8_LDB(B1, 0, 1); PG8_STAGE(PG8_SB(0, 0), b2, voffB);
            PG8_BAR; PG8_WAIT_L(0); PG8_MMA(0, 1, At, B1); PG8_BAR;
            PG8_LDA(At, 0, 1); PG8_STAGE(PG8_SA(0, 0), a2, voffA);
            PG8_BAR; PG8_WAIT_L(0); PG8_MMA(1, 0, At, B0); PG8_BAR; PG8_SCHED;
            PG8_STAGE(PG8_SB(0, 1), b2 + hstep, voffB);
            PG8_WAIT_V(6); PG8_BAR; PG8_MMA(1, 1, At, B1); PG8_BAR;
            PG8_LDB(B0, 1, 0); PG8_SCHED; PG8_LDA(At, 1, 0); PG8_STAGE(PG8_SA(0, 1), a2 + hstep, voffA);
            PG8_WAIT_L(8); PG8_BAR; PG8_WAIT_L(0); PG8_MMA(0, 0, At, B0); PG8_BAR; PG8_SCHED;
            PG8_LDB(B1, 1, 1); PG8_STAGE(PG8_SB(1, 0), b3, voffB);
            PG8_BAR; PG8_WAIT_L(0); PG8_MMA(0, 1, At, B1); PG8_BAR;
            PG8_LDA(At, 1, 1); PG8_STAGE(PG8_SA(1, 0), a3, voffA);
            PG8_BAR; PG8_WAIT_L(0); PG8_MMA(1, 0, At, B0); PG8_BAR; PG8_SCHED;
            PG8_STAGE(PG8_SB(1, 1), b3 + hstep, voffB);
            PG8_WAIT_V(6); PG8_BAR; PG8_MMA(1, 1, At, B1); PG8_BAR;
            }
        }
        if constexpr (ALIGN_EPI) { if (wr == 0) PG8_BAR; }
        if constexpr (!Epi::AFTER_DRAIN) { E(acc, cur, wr, wc, fr, fq); S.done(cur); }
        if (!has_next) break;
#pragma unroll
        for (int a = 0; a < 2; ++a)
#pragma unroll
            for (int b = 0; b < 2; ++b)
#pragma unroll
                for (int m = 0; m < 4; ++m)
#pragma unroll
                    for (int n = 0; n < 2; ++n) acc[a][b][m][n] = (f32x4){0.f, 0.f, 0.f, 0.f};
        cur = nxt; cA = nA; cB = nB; ++ui;
        if constexpr (ALIGN_EPI) { if (wr == 1) PG8_BAR; }
    }
    PG8_WAIT_V(0);
    if constexpr (!ALIGN_EPI) { if (wr == 0) PG8_BAR; }
    PG8_BAR;
#undef PG8_SA
#undef PG8_SB
#undef PG8_STAGE
#undef PG8_LDA
#undef PG8_LDB
#undef PG8_MMA
#undef PG8_WAIT_V
#undef PG8_WAIT_L
#undef PG8_BAR
#undef PG8_SCHED
}

typedef const f32x4 (&AccRef)[2][2][4][2];
__device__ __forceinline__ u32x4 pack8(f32x4 v0, f32x4 v1) { u32x4 w; w.x = cvtpk(v0[0], v0[1]); w.y = cvtpk(v0[2], v0[3]); w.z = cvtpk(v1[0], v1[1]); w.w = cvtpk(v1[2], v1[3]); return w; }
struct EpiMix {
    static constexpr bool PERM = true, AFTER_DRAIN = false;
    bf16_t* U; const float* rs;
    __device__ __forceinline__ void operator()(AccRef acc, const Unit& u, int wr, int wc, int fr, int fq) const {
        const int row0 = u.pm * BM + wr * 64 + fr; const int colt = u.pn * BM; const int sec = colt >> 9;
        float rv[2][4];
#pragma unroll
        for (int ai = 0; ai < 2; ++ai)
#pragma unroll
            for (int m = 0; m < 4; ++m) rv[ai][m] = rs[row0 + ai * HALF + m * 16];
        if (sec == S_CA || sec == S_CG) {
            bf16_t* base = U + (size_t)S_CA * SEC_ELEMS + ((colt - 1536 + wc * 32 + 8 * fq) >> 1);
#pragma unroll
            for (int ai = 0; ai < 2; ++ai)
#pragma unroll
                for (int m = 0; m < 4; ++m) { const int row = row0 + ai * HALF + m * 16; const float r = rv[ai][m]; bf16_t* rowp = base + (size_t)row * 512;
#pragma unroll
                    for (int bj = 0; bj < 2; ++bj) { const f32x4 av = acc[ai][bj][m][0] * r, gv = acc[ai][bj][m][1] * r; f32x4 h;
#pragma unroll
                        for (int j = 0; j < 4; ++j) h[j] = av[j] * sigmoidf_(gv[j]);
                        u32x2 w; w.x = cvtpk(h[0], h[1]); w.y = cvtpk(h[2], h[3]); *(u32x2*)(rowp + bj * 64) = w; } }
            return;
        }
        bf16_t* base = U + (size_t)sec * SEC_ELEMS; const float sc = (sec == S_NAQ || sec == S_DQ) ? QSCALE : 1.f;
        const int col0 = (colt & 511) + wc * 32 + 8 * fq;
#pragma unroll
        for (int ai = 0; ai < 2; ++ai)
#pragma unroll
            for (int m = 0; m < 4; ++m) { const int row = row0 + ai * HALF + m * 16; const float r = rv[ai][m] * sc; bf16_t* rowp = base + (size_t)row * 512 + col0;
#pragma unroll
                for (int bj = 0; bj < 2; ++bj) *(u32x4*)(rowp + bj * HALF) = pack8(acc[ai][bj][m][0] * r, acc[ai][bj][m][1] * r); }
    }
};
struct EpiY {
    static constexpr bool PERM = true, AFTER_DRAIN = false;
    bf16_t* Y; float* ss;
    __device__ __forceinline__ void operator()(AccRef acc, const Unit& u, int wr, int wc, int fr, int fq) const {
        const int row0 = u.pm * BM + wr * 64 + fr; const int col0 = u.pn * BM + wc * 32 + 8 * fq;
#pragma unroll
        for (int ai = 0; ai < 2; ++ai)
#pragma unroll
            for (int m = 0; m < 4; ++m) { const int row = row0 + ai * HALF + m * 16; bf16_t* rowp = Y + (size_t)row * DM + col0;
#pragma unroll
                for (int bj = 0; bj < 2; ++bj) { const f32x4 v0 = acc[ai][bj][m][0], v1 = acc[ai][bj][m][1];
                    float s = (v0[0] * v0[0] + v0[1] * v0[1]) + (v0[2] * v0[2] + v0[3] * v0[3]) + (v1[0] * v1[0] + v1[1] * v1[1]) + (v1[2] * v1[2] + v1[3] * v1[3]);
                    *(u32x4*)(rowp + bj * HALF) = pack8(v0, v1);
                    s += __shfl_xor(s, 16); s += __shfl_xor(s, 32);
                    if (fq == 0) ss[(size_t)row * 32 + u.pn * 8 + bj * 4 + wc] = s; } }
    }
};
struct EpiFfn {
    static constexpr bool PERM = true, AFTER_DRAIN = false;
    bf16_t* H; const float* rs;
    __device__ __forceinline__ void operator()(AccRef acc, const Unit& u, int wr, int wc, int fr, int fq) const {
        const int row0 = u.pm * BM + wr * 64 + fr; const int col0 = u.pn * 128 + wc * 16 + 4 * fq;
        float rv[2][4];
#pragma unroll
        for (int ai = 0; ai < 2; ++ai)
#pragma unroll
            for (int m = 0; m < 4; ++m) rv[ai][m] = rs[row0 + ai * HALF + m * 16];
        const int sel = fq & 1;
#pragma unroll
        for (int ai = 0; ai < 2; ++ai)
#pragma unroll
            for (int m = 0; m < 4; ++m) { const int row = row0 + ai * HALF + m * 16; const float r = rv[ai][m]; bf16_t* rowp = H + (size_t)row * FFH + col0;
                u32x2 w[2];
#pragma unroll
                for (int bj = 0; bj < 2; ++bj) { const f32x4 gv = acc[ai][bj][m][0] * r, uv = acc[ai][bj][m][1] * r; f32x4 h;
#pragma unroll
                    for (int j = 0; j < 4; ++j) h[j] = gv[j] * sigmoidf_(gv[j]) * uv[j];
                    w[bj].x = cvtpk(h[0], h[1]); w[bj].y = cvtpk(h[2], h[3]); }
                auto sx = __builtin_amdgcn_permlane16_swap(w[0].x, w[1].x, false, false); auto sy = __builtin_amdgcn_permlane16_swap(w[0].y, w[1].y, false, false);
                u32x4 o; o.x = sx[0]; o.y = sy[0]; o.z = sx[1]; o.w = sy[1];
                *(u32x4*)(rowp + sel * (64 - 4)) = o; }
    }
};
struct EpiGate {
    static constexpr bool PERM = true, AFTER_DRAIN = false;
    u32x4* g01; u32x4* g2; const float* rs; const float* bias;
    __device__ __forceinline__ void operator()(AccRef acc, const Unit& u, int wr, int wc, int fr, int fq) const {
        const int row0 = u.pm * BM + wr * 64 + fr; const int col0 = u.pn * BM + wc * 32 + 8 * fq;
        int t_ = threadIdx.x; asm volatile("" : "+v"(t_));
        const int br = u.pn >> 2;
        u32x4* slot = (br < 2 ? g01 + (size_t)br * (1280u * 16u * 512u) : g2) + (size_t)(u.pm * 4 + (u.pn & 3)) * (16 * 512) + t_;
        float rv[2][4];
#pragma unroll
        for (int ai = 0; ai < 2; ++ai)
#pragma unroll
            for (int m = 0; m < 4; ++m) rv[ai][m] = rs[row0 + ai * HALF + m * 16];
#pragma unroll
        for (int bj = 0; bj < 2; ++bj) { const f32x4 b0 = *(const f32x4*)(bias + col0 + bj * HALF), b1 = *(const f32x4*)(bias + col0 + bj * HALF + 4);
#pragma unroll
            for (int ai = 0; ai < 2; ++ai)
#pragma unroll
                for (int m = 0; m < 4; ++m) { const float r = rv[ai][m];
                    f32x4 v0 = acc[ai][bj][m][0] * r + b0, v1 = acc[ai][bj][m][1] * r + b1;
#pragma unroll
                    for (int j = 0; j < 4; ++j) { v0[j] = sigmoidf_(v0[j]); v1[j] = sigmoidf_(v1[j]); }
                    slot[(size_t)((ai * 4 + m) * 2 + bj) * 512] = pack8(v0, v1); } }
    }
};
struct EpiProj {
    static constexpr bool PERM = true, AFTER_DRAIN = false;
    const u32x4* g01; const u32x4* g2; bf16_t* merged;
    __device__ __forceinline__ void operator()(AccRef acc, const Unit& u, int wr, int wc, int fr, int fq) const {
        const int row0 = u.pm * BM + wr * 64 + fr; const int col0 = u.pn * BM + wc * 32 + 8 * fq;
        int t_ = threadIdx.x; asm volatile("" : "+v"(t_));
        const bool first = (u.z == 0);
        const u32x4* slot = (u.z < 2 ? g01 + (size_t)u.z * (1280u * 16u * 512u) : g2) + (size_t)(u.pm * 4 + u.pn) * (16 * 512) + t_;
#pragma unroll
        for (int ai = 0; ai < 2; ++ai) {
            u32x4 gw[4][2], ow[4][2];
#pragma unroll
            for (int m = 0; m < 4; ++m)
#pragma unroll
                for (int bj = 0; bj < 2; ++bj) { gw[m][bj] = slot[(size_t)((ai * 4 + m) * 2 + bj) * 512];
                    if (!first) ow[m][bj] = *(const u32x4*)(merged + (size_t)(row0 + ai * HALF + m * 16) * DM + col0 + bj * HALF); }
#pragma unroll
            for (int m = 0; m < 4; ++m) { bf16_t* rowp = merged + (size_t)(row0 + ai * HALF + m * 16) * DM + col0;
#pragma unroll
                for (int bj = 0; bj < 2; ++bj) { const u32x4 g = gw[m][bj];
                    f32x4 v0 = (f32x4){bflo(g.x), bfhi(g.x), bflo(g.y), bfhi(g.y)} * acc[ai][bj][m][0], v1 = (f32x4){bflo(g.z), bfhi(g.z), bflo(g.w), bfhi(g.w)} * acc[ai][bj][m][1];
                    if (!first) { const u32x4 o = ow[m][bj];
                        v0 += (f32x4){bflo(o.x), bfhi(o.x), bflo(o.y), bfhi(o.y)}; v1 += (f32x4){bflo(o.z), bfhi(o.z), bflo(o.w), bfhi(o.w)}; }
                    *(u32x4*)(rowp + bj * HALF) = pack8(v0, v1); } }
        }
    }
};
}

__device__ __forceinline__ unsigned offa(unsigned row, unsigned ch) { return 2048u * (row >> 3) + 512u * (ch >> 2) + 64u * (row & 7) + 16u * ((ch & 3) ^ ((row >> 2) & 3)); }
__device__ __forceinline__ int crow(int r, int hi) { return (r & 3) + 8 * (r >> 2) + 4 * hi; }
typedef short v4i16_t __attribute__((ext_vector_type(4)));
__device__ __forceinline__ s16x4 vtr(const LAS unsigned char* p) { return __builtin_bit_cast(s16x4, __builtin_amdgcn_ds_read_tr16_b64_v4i16((LAS v4i16_t*)p)); }
__device__ __forceinline__ unsigned kbase_of(int lane) { const unsigned r32 = lane & 31, hi = lane >> 5; return 2048u * (r32 >> 3) + 64u * (r32 & 7) + 16u * (hi ^ ((r32 >> 2) & 3)); }
__device__ __forceinline__ unsigned vbase_of(int lane) { const unsigned hi = lane >> 5, blk = (lane >> 4) & 1, q4 = (lane & 15) >> 2, p = lane & 3; return 64u * (4 * hi + q4) + 16u * ((2 * blk + (p >> 1)) ^ hi) + 8u * (p & 1); }
#define KFRAG(Kt, kb0, kb1, kh, c, s) (*(const LAS bf16x8*)((Kt) + (((s) & 1) ? (kb1) : (kb0)) + 8192 * (kh) + 512 * (2 * (c) + ((s) >> 1))))
__device__ __forceinline__ bf16x8 vfrag(const LAS unsigned char* Vt, unsigned vb0, unsigned vb1, int ks, int c4) {
    const s16x4 lo = vtr(Vt + vb0 + 4096 * ks + 512 * c4);
    const s16x4 hh = vtr(Vt + vb1 + 4096 * ks + 2048 + 512 * c4);
    return (bf16x8){lo[0], lo[1], lo[2], lo[3], hh[0], hh[1], hh[2], hh[3]};
}
__device__ __forceinline__ float rowmax32(const f32x16& a, const f32x16& b) {
    float m0 = fmaxf(a[0], b[0]), m1 = fmaxf(a[1], b[1]);
#pragma unroll
    for (int r = 2; r < 16; r += 2) { m0 = fmaxf(m0, fmaxf(a[r], b[r])); m1 = fmaxf(m1, fmaxf(a[r + 1], b[r + 1])); }
    const float m = fmaxf(m0, m1);
    auto rr = __builtin_amdgcn_permlane32_swap(__float_as_uint(m), __float_as_uint(m), false, false);
    return fmaxf(__uint_as_float(rr[0]), __uint_as_float(rr[1]));
}
__device__ __forceinline__ float xhalf_sum(float v) {
    auto rr = __builtin_amdgcn_permlane32_swap(__float_as_uint(v), __float_as_uint(v), false, false);
    return __uint_as_float(rr[0]) + __uint_as_float(rr[1]);
}
__device__ __forceinline__ float exp_pack(f32x16& s0, f32x16& s1, float mm, bf16x8* P) {
    float sum0 = 0.f, sum1 = 0.f;
#pragma unroll
    for (int r = 0; r < 16; ++r) { s0[r] = __builtin_amdgcn_exp2f(s0[r] - mm); s1[r] = __builtin_amdgcn_exp2f(s1[r] - mm); sum0 += s0[r]; sum1 += s1[r]; }
#pragma unroll
    for (int sp = 0; sp < 2; ++sp) {
        u32x4 w0, w1;
        w0.x = cvtpk(s0[8 * sp + 0], s0[8 * sp + 1]); w0.y = cvtpk(s0[8 * sp + 2], s0[8 * sp + 3]); w0.z = cvtpk(s0[8 * sp + 4], s0[8 * sp + 5]); w0.w = cvtpk(s0[8 * sp + 6], s0[8 * sp + 7]);
        w1.x = cvtpk(s1[8 * sp + 0], s1[8 * sp + 1]); w1.y = cvtpk(s1[8 * sp + 2], s1[8 * sp + 3]); w1.z = cvtpk(s1[8 * sp + 4], s1[8 * sp + 5]); w1.w = cvtpk(s1[8 * sp + 6], s1[8 * sp + 7]);
        P[sp] = __builtin_bit_cast(bf16x8, w0); P[2 + sp] = __builtin_bit_cast(bf16x8, w1);
    }
    return sum0 + sum1;
}
__device__ __forceinline__ void chunk_rc(int n, int& row, int& ch) { row = ((n >> 5) << 1) | ((n >> 2) & 1); ch = (((n >> 3) & 3) << 2) | (n & 3); }

__device__ __forceinline__ size_t dma_goff(int pc, int lane, int pitch) {
    const unsigned o = pc * 1024u + lane * 16u; const unsigned r8 = o >> 11, chh = (o >> 9) & 3, rl = (o >> 6) & 7, x = (o >> 4) & 3;
    const unsigned row = 8 * r8 + rl, ch = 4 * chh + (x ^ ((row >> 2) & 3));
    return (size_t)row * pitch + ch * 8;
}
#define GLDS16(gptr, ldsptr) __builtin_amdgcn_global_load_lds((const unsigned*)(gptr), (LAS unsigned*)(ldsptr), 16, 0, 0)

template <bool HAS_QK, bool HAS_PV>
__device__ __forceinline__ void diff_step(const LAS unsigned char* Kt, const LAS unsigned char* Vp, const LAS float* tab, const bf16x8 (&qf)[4], f32x16 (&O)[4], bf16x8 (&P)[4],
                                          float& mrun, float& lrun, float beta, int ib0, unsigned kb0, unsigned kb1, unsigned vb0, unsigned vb1, bool NEAR, bool first = false) {
    f32x16 s0, s1;
    if (HAS_QK) {
        const float c0 = beta - mrun;
#pragma unroll
        for (int r = 0; r < 16; ++r) { s0[r] = c0; s1[r] = c0; }
#pragma unroll
        for (int s4 = 0; s4 < 4; ++s4) {
            const bf16x8 a0 = KFRAG(Kt, kb0, kb1, 0, 0, s4), a1 = KFRAG(Kt, kb0, kb1, 1, 0, s4);
            s0 = __builtin_amdgcn_mfma_f32_32x32x16_bf16(a0, qf[s4], s0, 0, 0, 0);
            s1 = __builtin_amdgcn_mfma_f32_32x32x16_bf16(a1, qf[s4], s1, 0, 0, 0);
        }
    }
    if (HAS_PV) {
#pragma unroll
        for (int ks = 0; ks < 2; ++ks)
#pragma unroll
            for (int c4 = 0; c4 < 4; ++c4) { const bf16x8 vf = vfrag(Vp, vb0, vb1, ks, c4); O[c4] = __builtin_amdgcn_mfma_f32_32x32x16_bf16(vf, P[ks], O[c4], 0, 0, 0); }
    }
    float f = 1.f; bool need = false;
    if (HAS_QK) {
        if (NEAR) {
#pragma unroll
            for (int r = 0; r < 16; ++r) { int i0 = ib0 + (r & 3) + 8 * (r >> 2), i1 = i0 + 32; i0 = min(max(i0, 0), 256); i1 = min(max(i1, 0), 256); s0[r] += tab[i0]; s1[r] += tab[i1]; }
        }
        const float rm = rowmax32(s0, s1);
        need = first || __any(rm > 8.f);
        if (need) { const float dl = first ? rm : fmaxf(rm, 0.f); mrun += dl; f = first ? 1.f : __builtin_amdgcn_exp2f(-dl);
#pragma unroll
            for (int r = 0; r < 16; ++r) { s0[r] -= dl; s1[r] -= dl; } }
    }
    if (HAS_PV) {
#pragma unroll
        for (int ks = 2; ks < 4; ++ks)
#pragma unroll
            for (int c4 = 0; c4 < 4; ++c4) { const bf16x8 vf = vfrag(Vp, vb0, vb1, ks, c4); O[c4] = __builtin_amdgcn_mfma_f32_32x32x16_bf16(vf, P[ks], O[c4], 0, 0, 0); }
    }
    if (HAS_QK) {
        float sum0 = 0.f, sum1 = 0.f;
#pragma unroll
        for (int r = 0; r < 16; ++r) { s0[r] = __builtin_amdgcn_exp2f(s0[r]); s1[r] = __builtin_amdgcn_exp2f(s1[r]); sum0 += s0[r]; sum1 += s1[r]; }
#pragma unroll
        for (int sp = 0; sp < 2; ++sp) {
            u32x4 w0, w1;
            w0.x = cvtpk(s0[8 * sp + 0], s0[8 * sp + 1]); w0.y = cvtpk(s0[8 * sp + 2], s0[8 * sp + 3]); w0.z = cvtpk(s0[8 * sp + 4], s0[8 * sp + 5]); w0.w = cvtpk(s0[8 * sp + 6], s0[8 * sp + 7]);
            w1.x = cvtpk(s1[8 * sp + 0], s1[8 * sp + 1]); w1.y = cvtpk(s1[8 * sp + 2], s1[8 * sp + 3]); w1.z = cvtpk(s1[8 * sp + 4], s1[8 * sp + 5]); w1.w = cvtpk(s1[8 * sp + 6], s1[8 * sp + 7]);
            P[sp] = __builtin_bit_cast(bf16x8, w0); P[2 + sp] = __builtin_bit_cast(bf16x8, w1);
        }
        if (need && !first) {
#pragma unroll
            for (int e = 0; e < 4; ++e) O[e] *= f;
        }
        lrun = lrun * f + (sum0 + sum1);
    }
}

__device__ __forceinline__ void diff_unit(LAS unsigned char* lds, const bf16_t* __restrict__ Kg, const bf16_t* __restrict__ Vg, bf16_t* QO,
                                          long R0, int S, int hd, int qblk, float lam, float oscale, const float* __restrict__ subg, int dry = 0) {
    int tid = threadIdx.x; asm volatile("" : "+v"(tid));
    const int lane = tid & 63, wid = __builtin_amdgcn_readfirstlane(tid >> 6), r32 = lane & 31, hi = lane >> 5;
    const int qg = wid >> 1, cmap = wid & 1;
    const LAS float* tab = (const LAS float*)(lds + LDS_TAB) + hd * 257;
    const int q0w = qblk * 128 + qg * 32;
    bf16_t* Qrow = QO + (size_t)(R0 + q0w + r32) * 512 + hd * 128;
    bf16x8 qf[4];
#pragma unroll
    for (int s = 0; s < 4; ++s) qf[s] = *(const bf16x8*)(Qrow + cmap * 64 + s * 16 + hi * 8);
    const bf16_t* kbase = Kg + (size_t)R0 * 512 + hd * 128;
    const bf16_t* vbase = Vg + (size_t)R0 * 512 + hd * 128;
    const size_t g0 = dma_goff(wid, lane, 512), g1 = dma_goff(wid + 8, lane, 512);
    const unsigned d0 = wid * 1024u, d1 = (wid + 8) * 1024u;
    const unsigned kb0 = kbase_of(lane), kb1 = kb0 ^ 32u, vb0 = vbase_of(lane), vb1 = vb0 ^ 32u;
    const int nt = S / 64;
#define DIFF_DMA2(st, boff) do { const size_t go = (size_t)(st) * 128 * 512; LAS unsigned char* b_ = lds + (boff); \
        GLDS16(kbase + go + g0, b_ + d0); GLDS16(kbase + go + g1, b_ + d1); GLDS16(vbase + go + g0, b_ + 16384 + d0); GLDS16(vbase + go + g1, b_ + 16384 + d1); \
        GLDS16(kbase + go + 64 * 512 + g0, b_ + 32768 + d0); GLDS16(kbase + go + 64 * 512 + g1, b_ + 32768 + d1); GLDS16(vbase + go + 64 * 512 + g0, b_ + 49152 + d0); GLDS16(vbase + go + 64 * 512 + g1, b_ + 49152 + d1); } while (0)
    DIFF_DMA2(0, 0);
    float mrun = 0.f, lrun = 0.f;
    f32x16 O[4]; bf16x8 P[4];
#pragma unroll
    for (int e = 0; e < 4; ++e) { O[e] = (f32x16){}; P[e] = (bf16x8){}; }
    const int qidx = q0w + r32;
    const int ibq = 128 + 4 * hi - qidx;
    const int ns = nt >> 1;
    __syncthreads();
    if (wid >= 4) __builtin_amdgcn_s_setprio(1);
#pragma unroll 1
    for (int st = 0; st < ns; ++st) {
        const unsigned bb = (st & 1) * 65536u;
        if (st + 1 < ns) DIFF_DMA2(st + 1, ((st + 1) & 1) * 65536u);
        const LAS unsigned char* KA = lds + bb + cmap * 1024; const LAS unsigned char* VA = lds + bb + 16384;
        const LAS unsigned char* KB = lds + bb + 32768 + cmap * 1024; const LAS unsigned char* VB = lds + bb + 49152;
        { const int kq = st * 128;
          const bool farR = (kq - q0w - 31 >= 91), farL = (kq + 63 - q0w <= -91), nr = !(farR || farL);
          diff_step<true, false>(KA, VA, tab, qf, O, P, mrun, lrun, nr ? 0.f : (farR ? tab[256] : tab[0]), kq + ibq, kb0, kb1, vb0, vb1, nr, st == 0); }
        { const int kq = st * 128 + 64;
          const bool farR = (kq - q0w - 31 >= 91), farL = (kq + 63 - q0w <= -91), nr = !(farR || farL);
          diff_step<true, true>(KB, VA, tab, qf, O, P, mrun, lrun, nr ? 0.f : (farR ? tab[256] : tab[0]), kq + ibq, kb0, kb1, vb0, vb1, nr); }
        diff_step<false, true>(KB, VB, tab, qf, O, P, mrun, lrun, 0.f, 0, kb0, kb1, vb0, vb1, false);
        __syncthreads();
    }
#undef DIFF_DMA2
    __builtin_amdgcn_s_setprio(0);
    const float il = __builtin_amdgcn_rcpf(xhalf_sum(lrun));
    LAS f32x4* xb = (LAS f32x4*)(lds + qg * 16384) + lane;
    if (cmap == 1) {
        const float sc = il * lam;
#pragma unroll
        for (int e = 0; e < 4; ++e)
#pragma unroll
            for (int g = 0; g < 4; ++g) xb[(e * 4 + g) * 64] = (f32x4){O[e][4 * g + 0], O[e][4 * g + 1], O[e][4 * g + 2], O[e][4 * g + 3]} * sc;
    }
    __syncthreads();
    if (cmap == 0 && !dry) {
        bf16_t* Qrow2 = QO + (size_t)(R0 + q0w + r32) * 512 + hd * 128;
        float ssq = 0.f;
#pragma unroll
        for (int e = 0; e < 4; ++e)
#pragma unroll
            for (int g = 0; g < 4; ++g) { const f32x4 o1 = xb[(e * 4 + g) * 64];
#pragma unroll
                for (int j = 0; j < 4; ++j) { const float o = O[e][4 * g + j] * il - o1[j]; O[e][4 * g + j] = o; ssq += o * o; } }
        ssq = xhalf_sum(ssq);
        const float rn = rsqrtf(ssq * (1.f / 128.f) + EPS) * oscale;
#pragma unroll
        for (int e = 0; e < 4; ++e)
#pragma unroll
            for (int gp = 0; gp < 2; ++gp) { u32x2 w[2];
#pragma unroll
                for (int k = 0; k < 2; ++k) { const int g = 2 * gp + k; const int ecol = 32 * e + 8 * g + 4 * hi; const f32x4 gv = *(const f32x4*)(subg + ecol);
                    w[k].x = cvtpk(O[e][4 * g + 0] * rn * gv[0], O[e][4 * g + 1] * rn * gv[1]); w[k].y = cvtpk(O[e][4 * g + 2] * rn * gv[2], O[e][4 * g + 3] * rn * gv[3]); }
                auto sx = __builtin_amdgcn_permlane32_swap(w[0].x, w[1].x, false, false); auto sy = __builtin_amdgcn_permlane32_swap(w[0].y, w[1].y, false, false);
                u32x4 o; o.x = sx[0]; o.y = sy[0]; o.z = sx[1]; o.w = sy[1];
                *(u32x4*)(Qrow2 + 32 * e + 8 * (2 * gp + hi)) = o; }
    }
    __syncthreads();
}

__device__ __forceinline__ void na_unit(LAS unsigned char* lds, const bf16_t* __restrict__ Kg, const bf16_t* __restrict__ Vg, bf16_t* QO,
                                        long R0, int rows, int r0, int hpair, int dry = 0) {
    int tid = threadIdx.x; asm volatile("" : "+v"(tid));
    const int lane = tid & 63, wid = __builtin_amdgcn_readfirstlane(tid >> 6), r32 = lane & 31, hi = lane >> 5;
    const int rr = wid >> 2, hh = (wid >> 1) & 1, half = wid & 1, head = 2 * hpair + hh, r = r0 + rr;
    const LAS float* tab = (const LAS float*)(lds + LDS_TAB) + head * 465;
    int rs = r - 4; rs = rs < 0 ? 0 : (rs > rows - 8 ? rows - 8 : rs);
    int rs0 = r0 - 4; rs0 = rs0 < 0 ? 0 : (rs0 > rows - 8 ? rows - 8 : rs0);
    int rs1 = r0 - 3; rs1 = rs1 < 0 ? 0 : (rs1 > rows - 8 ? rows - 8 : rs1);
    const int nst = rs1 + 8 - rs0;
    const int c = 32 * half + r32;
    int cs = c - 8; cs = cs < 0 ? 0 : (cs > 48 ? 48 : cs);
    const unsigned long long wmask = 0xFFFFull << cs; const unsigned mlo = (unsigned)wmask, mhi = (unsigned)(wmask >> 32);
    const int ibase = 15 - c + 4 * hi;
    bf16_t* Qrow = QO + (size_t)(R0 + (size_t)r * 64 + c) * 512 + head * 64;
    bf16x8 qf[4];
#pragma unroll
    for (int s = 0; s < 4; ++s) qf[s] = *(const bf16x8*)(Qrow + s * 16 + hi * 8);
    const bf16_t* kbase = Kg + (size_t)(R0 + (size_t)rs0 * 64) * 512 + hpair * 128;
    const bf16_t* vbase = Vg + (size_t)(R0 + (size_t)rs0 * 64) * 512 + hpair * 128;
    const unsigned g0 = dma_goff(wid, lane, 512), g1 = dma_goff(wid + 8, lane, 512);
    const unsigned d0 = wid * 1024u, d1 = (wid + 8) * 1024u;
    const unsigned kb0 = kbase_of(lane), kb1 = kb0 ^ 32u, vb0 = vbase_of(lane), vb1 = vb0 ^ 32u;
#define NA_DMA(st, boff) do { const size_t go = (size_t)(st) * 64 * 512; LAS unsigned char* b_ = lds + (boff); \
        GLDS16(kbase + go + g0, b_ + d0); GLDS16(kbase + go + g1, b_ + d1); GLDS16(vbase + go + g0, b_ + 16384 + d0); GLDS16(vbase + go + g1, b_ + 16384 + d1); } while (0)
    const int nst2 = (nst + 1) >> 1;
    NA_DMA(0, 0); NA_DMA(1, 32768);
    __syncthreads();
    float mrun = -1e30f, lrun = 0.f;
    f32x16 O[2]; O[0] = (f32x16){}; O[1] = (f32x16){};
#pragma unroll 1
    for (int s2 = 0; s2 < nst2; ++s2) {
        const unsigned bb = (s2 & 1) * 65536u;
        if (s2 + 1 < nst2) { const unsigned nb = ((s2 + 1) & 1) * 65536u; NA_DMA(2 * s2 + 2, nb); if (2 * s2 + 3 < nst) NA_DMA(2 * s2 + 3, nb + 32768); }
#pragma unroll 1
        for (int sub = 0; sub < 2; ++sub) {
        const int st = 2 * s2 + sub;
        const LAS unsigned char* Kt = lds + bb + sub * 32768; const LAS unsigned char* Vt = Kt + 16384;
        const int ku = rs0 + st;
        if (st < nst && ku >= rs && ku < rs + 8) {
            f32x16 s0 = (f32x16){}, s1 = (f32x16){};
#pragma unroll
            for (int s4 = 0; s4 < 4; ++s4) {
                const bf16x8 a0 = KFRAG(Kt, kb0, kb1, 0, hh, s4), a1 = KFRAG(Kt, kb0, kb1, 1, hh, s4);
                s0 = __builtin_amdgcn_mfma_f32_32x32x16_bf16(a0, qf[s4], s0, 0, 0, 0);
                s1 = __builtin_amdgcn_mfma_f32_32x32x16_bf16(a1, qf[s4], s1, 0, 0, 0);
            }
            const LAS float* trow = tab + (ku - r + 7) * 31;
#pragma unroll
            for (int q = 0; q < 16; ++q) { const int ko = (q & 3) + 8 * (q >> 2);
                int i0 = ibase + ko, i1 = ibase + ko + 32; i0 = min(max(i0, 0), 30); i1 = min(max(i1, 0), 30);
                const float b0 = trow[i0], b1 = trow[i1];
                const float p0 = (float)((mlo >> (ko + 4 * hi)) & 1u), p1 = (float)((mhi >> (ko + 4 * hi)) & 1u);
                s0[q] = s0[q] + b0 + (p0 - 1.f) * 1e30f; s1[q] = s1[q] + b1 + (p1 - 1.f) * 1e30f; }
            const float rm = rowmax32(s0, s1);
            if (__any(rm > mrun + 8.f)) { const float mn = fmaxf(mrun, rm), f = __builtin_amdgcn_exp2f(mrun - mn); lrun *= f; mrun = mn; O[0] *= f; O[1] *= f; }
            bf16x8 P[4];
            lrun += exp_pack(s0, s1, mrun, P);
#pragma unroll
            for (int ks = 0; ks < 4; ++ks)
#pragma unroll
                for (int e = 0; e < 2; ++e) { const bf16x8 vf = vfrag(Vt, vb0, vb1, ks, 2 * hh + e); O[e] = __builtin_amdgcn_mfma_f32_32x32x16_bf16(vf, P[ks], O[e], 0, 0, 0); }
        }
        }
        __syncthreads();
    }
#undef NA_DMA
    __builtin_amdgcn_s_setprio(0);
    const float il = __builtin_amdgcn_rcpf(xhalf_sum(lrun));
    if (!dry) {
#pragma unroll
        for (int e = 0; e < 2; ++e)
#pragma unroll
            for (int gp = 0; gp < 2; ++gp) { u32x2 w[2];
#pragma unroll
                for (int k = 0; k < 2; ++k) { const int g = 2 * gp + k; w[k].x = cvtpk(O[e][4 * g + 0] * il, O[e][4 * g + 1] * il); w[k].y = cvtpk(O[e][4 * g + 2] * il, O[e][4 * g + 3] * il); }
                auto sx = __builtin_amdgcn_permlane32_swap(w[0].x, w[1].x, false, false); auto sy = __builtin_amdgcn_permlane32_swap(w[0].y, w[1].y, false, false);
                u32x4 o; o.x = sx[0]; o.y = sy[0]; o.z = sx[1]; o.w = sy[1];
                *(u32x4*)(Qrow + 32 * e + 8 * (2 * gp + hi)) = o; }
    }
}

__device__ __forceinline__ void conv_unit(LAS unsigned char* lds, const bf16_t* __restrict__ CA, const bf16_t* __restrict__ CG, bf16_t* __restrict__ OCV,
                                          const f32x2 (&w)[31], const f32x2 bv, const f32x4 (&lnp)[4], int tid,
                                          long R0, int S, int t0, bool preloaded, bool has_next, long nR0, int nS, int nt0) {
    const int lane = tid & 63, wid = tid >> 6;
    if (!preloaded) {
        u32x4 av[8];
#pragma unroll
        for (int it = 0; it < 8; ++it) { const int n = tid + it * 512; int row = n >> 6; row = row > 61 ? 61 : row; const int ch = n & 63; int tok = t0 - 15 + row; tok = tok < 0 ? 0 : (tok > S - 1 ? S - 1 : tok);
            av[it] = *(const u32x4*)(CA + (size_t)(R0 + tok) * 512 + ch * 8); }
#pragma unroll
        for (int it = 0; it < 8; ++it) { const int n = tid + it * 512; const int row = n >> 6, ch = n & 63; const int tok = t0 - 15 + row;
            u32x4 w = av[it]; if (tok < 0 || tok >= S) w = (u32x4){0u, 0u, 0u, 0u};
            if (row < 62) *(LAS u32x4*)(lds + (size_t)row * 1024 + ch * 16) = w; }
    }
    __syncthreads();
    {   const int cp = tid & 255, th = tid >> 8;
        for (int hf = 0; hf < 2; ++hf) {
            const int tb = 16 * th + 8 * hf;
            f32x2 acc[8];
#pragma unroll
            for (int i = 0; i < 8; ++i) acc[i] = bv;
            const LAS unsigned* xin = (const LAS unsigned*)lds + tb * 256 + cp;
#pragma unroll
            for (int j = 0; j < 38; ++j) { const unsigned xu = xin[j * 256]; const f32x2 x = {bflo(xu), bfhi(xu)};
#pragma unroll
                for (int i = 0; i < 8; ++i) { const int k = j - i; if (k >= 0 && k <= 30) acc[i] += w[k] * x; }
                if ((j & 3) == 3) asm volatile("" ::: "memory"); }
            LAS f32x2* co = (LAS f32x2*)(lds + 65536) + tb * 256 + cp;
#pragma unroll
            for (int i = 0; i < 8; ++i) co[i * 256] = acc[i];
        }
    }
    __syncthreads();
    u32x4 nav[8];
    if (has_next) {
#pragma unroll
        for (int it = 0; it < 8; ++it) { const int n = tid + it * 512; int row = n >> 6; row = row > 61 ? 61 : row; const int ch = n & 63; int tok = nt0 - 15 + row; tok = tok < 0 ? 0 : (tok > nS - 1 ? nS - 1 : tok);
            nav[it] = *(const u32x4*)(CA + (size_t)(nR0 + tok) * 512 + ch * 8); }
    }
    {
        const f32x4 g0 = lnp[0], g1 = lnp[1], b0 = lnp[2], b1 = lnp[3];
#pragma unroll
        for (int i = 0; i < 4; ++i) { const int tok = 4 * wid + i;
            const LAS f32x4* cr = (const LAS f32x4*)(lds + 65536 + (size_t)tok * 2048) + 2 * lane;
            f32x4 v0 = cr[0], v1 = cr[1];
            const float mean = wave_sum((v0[0] + v0[1]) + (v0[2] + v0[3]) + (v1[0] + v1[1]) + (v1[2] + v1[3])) * (1.f / 512.f);
            v0 = v0 - mean; v1 = v1 - mean;
            const float var = wave_sum((v0[0] * v0[0] + v0[1] * v0[1]) + (v0[2] * v0[2] + v0[3] * v0[3]) + (v1[0] * v1[0] + v1[1] * v1[1]) + (v1[2] * v1[2] + v1[3] * v1[3])) * (1.f / 512.f);
            const float rstd = rsqrtf(var + EPS);
            v0 = v0 * rstd * g0 + b0; v1 = v1 * rstd * g1 + b1;
#pragma unroll
            for (int j = 0; j < 4; ++j) { v0[j] = v0[j] * sigmoidf_(v0[j]); v1[j] = v1[j] * sigmoidf_(v1[j]); }
            { u32x4 w; w.x = cvtpk(v0[0], v0[1]); w.y = cvtpk(v0[2], v0[3]); w.z = cvtpk(v1[0], v1[1]); w.w = cvtpk(v1[2], v1[3]); *(u32x4*)(OCV + (size_t)(R0 + t0 + tok) * 512 + 8 * lane) = w; } }
    }
    if (has_next) {
#pragma unroll
        for (int it = 0; it < 8; ++it) { const int n = tid + it * 512; const int row = n >> 6, ch = n & 63; const int tok = nt0 - 15 + row;
            u32x4 w = nav[it]; if (tok < 0 || tok >= nS) w = (u32x4){0u, 0u, 0u, 0u};
            if (row < 62) *(LAS u32x4*)(lds + (size_t)row * 1024 + ch * 16) = w; }
    } else __syncthreads();
}

__device__ __forceinline__ int t5_bucket(int rel) {
    const int ret = rel > 0 ? 16 : 0; const int n = rel < 0 ? -rel : rel;
    if (n < 8) return ret + n;
    const float nf = (float)n;
    int large = 8 + (int)(logf(nf / 8.f) / 2.772588722239781f * 8.f);
    large = large > 15 ? 15 : large;
    return ret + large;
}
__device__ __forceinline__ void wprep_item(const float* __restrict__ W, int ldw, int K, bf16_t* WT, int nblk, int item, int mode, int coloff, const float* __restrict__ gain, LAS float* scr, int lane) {
    const int kb = item / nblk, nb = item % nblk, k0 = 64 * kb, n0 = 32 * nb;
    const int r8 = lane >> 3, c8 = lane & 7;
    const int np = n0 + 4 * c8;
    int sc;
    if (mode == 1) sc = ((np & 7) < 4) ? 4 * (np >> 3) + (np & 7) : FFH + 4 * (np >> 3) + (np & 7) - 4;
    else if (mode == 2 && np >= 1536 && np < 2560) { const int q = np - 1536; sc = ((q & 7) < 4) ? 1536 + 4 * (q >> 3) + (q & 7) : 2048 + 4 * (q >> 3) + (q & 7) - 4; }
    else sc = coloff + np;
#pragma unroll
    for (int i = 0; i < 8; ++i) { const int kk = 8 * i + r8; f32x4 v = *(const f32x4*)(W + (size_t)(k0 + kk) * ldw + sc); if (gain) v = v * gain[k0 + kk];
        LAS float* d = scr + kk * 33 + 4 * c8; d[0] = v[0]; d[1] = v[1]; d[2] = v[2]; d[3] = v[3]; }
    asm volatile("s_waitcnt lgkmcnt(0)" ::: "memory");
    const int c = lane & 7;
#pragma unroll
    for (int j = 0; j < 4; ++j) { const int n = (lane >> 3) + 8 * j; const LAS float* s = scr + (8 * c) * 33 + n;
        u32x4 o; o.x = cvtpk(s[0 * 33], s[1 * 33]); o.y = cvtpk(s[2 * 33], s[3 * 33]); o.z = cvtpk(s[4 * 33], s[5 * 33]); o.w = cvtpk(s[6 * 33], s[7 * 33]);
        *(u32x4*)(WT + (size_t)(n0 + n) * K + k0 + 8 * c) = o; }
    asm volatile("s_waitcnt lgkmcnt(0)" ::: "memory");
}

#define XB_TMO      128
#define XB_XCNT(j)  (256  + 64 * (j))
#define XB_XSUB(j)  (1280 + 64 * (j))
#define XB_XGEN(j)  (2304 + 64 * (j))
#define XB_TOP      3328
#define XB_TOPGEN   3392
#define XCD_BAR_WORDS 3456
#define XB_SPIN_CAP (1u << 22)

__device__ __forceinline__ unsigned xb_ld(unsigned* p)              { return __hip_atomic_load(p, __ATOMIC_RELAXED, __HIP_MEMORY_SCOPE_AGENT); }
__device__ __forceinline__ unsigned xb_add(unsigned* p, unsigned v) { return __hip_atomic_fetch_add(p, v, __ATOMIC_RELAXED, __HIP_MEMORY_SCOPE_AGENT); }
__device__ __forceinline__ unsigned xb_xcc_id() { return (unsigned)__builtin_amdgcn_s_getreg((3 << 11) | 20) & 0xFu; }
#define XB_SPIN(cond, bar) do { unsigned _sp = 0; while (cond) { __builtin_amdgcn_s_sleep(1); \
    if ((++_sp & 255u) == 0u) { if (xb_ld(&(bar)[XB_TMO])) break; if (_sp > XB_SPIN_CAP) { atomicAdd(&(bar)[XB_TMO], 1u); break; } } } } while (0)

struct XcdBarrier {
    unsigned* bar; unsigned x;
    volatile LAS unsigned* st;
};

__device__ __forceinline__ XcdBarrier xcd_barrier_post(unsigned* bar, volatile LAS unsigned* st) {
    XcdBarrier b; b.bar = bar; b.x = xb_xcc_id(); b.st = st;
    if (threadIdx.x == 0) (void)xb_add(&bar[XB_XCNT(b.x)], 1u);
    return b;
}
__device__ __forceinline__ void xcd_barrier_complete(unsigned* bar, unsigned x, unsigned& nloc, unsigned& nx) {
    const unsigned G = gridDim.x * gridDim.y * gridDim.z;
    unsigned sum, cnt, mine, sp = 0u;
    for (;;) {
        sum = 0u; cnt = 0u; mine = 0u;
#pragma unroll
        for (unsigned j = 0; j < 16; ++j) { const unsigned c = xb_ld(&bar[XB_XCNT(j)]); sum += c; cnt += (c > 0u) ? 1u : 0u; mine = (j == x) ? c : mine; }
        if (sum == G) break;
        __builtin_amdgcn_s_sleep(1);
        if ((++sp & 255u) == 0u) { if (xb_ld(&bar[XB_TMO])) break; if (sp > XB_SPIN_CAP) { atomicAdd(&bar[XB_TMO], 1u); break; } }
    }
    nloc = mine > 0u ? mine : 1u; nx = cnt > 0u ? cnt : 1u;
}

__device__ __forceinline__ void xcd_barrier(const XcdBarrier& b) {
    asm volatile("s_waitcnt vmcnt(0)" ::: "memory");
    __syncthreads();
    if (threadIdx.x == 0) {
        unsigned* bar = b.bar;
        __builtin_amdgcn_s_waitcnt(0);
        unsigned nloc = b.st[0], nx = b.st[1];
        if (nloc == 0u) { xcd_barrier_complete(bar, b.x, nloc, nx); b.st[0] = nloc; b.st[1] = nx; }
        const unsigned old = xb_add(&bar[XB_XSUB(b.x)], 1u);
        const unsigned gen = old / nloc;
        if (old + 1u == (gen + 1u) * nloc) {
            __builtin_amdgcn_fence(__ATOMIC_RELEASE, "agent");
            asm volatile("s_waitcnt vmcnt(0)" ::: "memory");
            const unsigned og = xb_add(&bar[XB_TOP], 1u);
            const unsigned tg = og / nx;
            if (og + 1u == (tg + 1u) * nx) xb_add(&bar[XB_TOPGEN], 1u);
            else XB_SPIN(xb_ld(&bar[XB_TOPGEN]) == tg, bar);
            __builtin_amdgcn_fence(__ATOMIC_ACQUIRE, "agent");
            xb_add(&bar[XB_XGEN(b.x)], 1u);
            asm volatile("s_waitcnt vmcnt(0)" ::: "memory");
        } else {
            XB_SPIN(xb_ld(&bar[XB_XGEN(b.x)]) == gen, bar);
            __builtin_amdgcn_fence(__ATOMIC_ACQUIRE, "agent");
            asm volatile("s_waitcnt vmcnt(0)" ::: "memory");
        }
    }
    __syncthreads();
}

struct Params {
    const float* in[20];
    float* out;
    unsigned char* ws;
    int ph_lo, ph_hi;
};
enum { I_XP = 0, I_XS, I_WIN, I_BGATE, I_RPB, I_DWW, I_DWB, I_CLG, I_CLB, I_LAM, I_SUBG, I_T5, I_WBR, I_WOUT, I_LMPRE, I_LMPOST, I_LFPRE, I_LFPOST, I_WF1, I_WF2 };

__device__ __forceinline__ void row_prep(const float* __restrict__ xrow, bf16_t* xbrow, float* rs, int row, int lane) {
    const f32x4* xr = (const f32x4*)xrow + lane; f32x4 v[4]; float s = 0.f;
#pragma unroll
    for (int j = 0; j < 4; ++j) { v[j] = xr[64 * j]; s += (v[j][0] * v[j][0] + v[j][1] * v[j][1]) + (v[j][2] * v[j][2] + v[j][3] * v[j][3]); }
    s = wave_sum(s);
    u32x2* o = (u32x2*)xbrow + lane;
#pragma unroll
    for (int j = 0; j < 4; ++j) { u32x2 w; w.x = cvtpk(v[j][0], v[j][1]); w.y = cvtpk(v[j][2], v[j][3]); o[64 * j] = w; }
    if (lane == 0) rs[row] = rsqrtf(s * (1.f / DM) + EPS);
}
__device__ __forceinline__ void row_final(const float* __restrict__ xrow, const bf16_t* __restrict__ yrow, const float* __restrict__ ssp, const float* __restrict__ gpost, float* orow, bf16_t* xbrow, float* rs, int row, int lane) {
    const float ssv = wave_sum(lane < 32 ? ssp[lane] : 0.f);
    const float rn = rsqrtf(ssv * (1.f / DM) + EPS);
    const f32x4* xr = (const f32x4*)xrow + lane; const u32x2* yr = (const u32x2*)yrow + lane; const f32x4* gr = (const f32x4*)gpost + lane;
    f32x4 v[4]; float s = 0.f;
#pragma unroll
    for (int j = 0; j < 4; ++j) { const f32x4 x = xr[64 * j], g = gr[64 * j]; const u32x2 y = yr[64 * j];
        const f32x4 yf = {bflo(y.x), bfhi(y.x), bflo(y.y), bfhi(y.y)};
        v[j] = x + yf * rn * g; s += (v[j][0] * v[j][0] + v[j][1] * v[j][1]) + (v[j][2] * v[j][2] + v[j][3] * v[j][3]); }
    s = wave_sum(s);
    f32x4* oo = (f32x4*)orow + lane; u32x2* o = (u32x2*)xbrow + lane;
#pragma unroll
    for (int j = 0; j < 4; ++j) { oo[64 * j] = v[j]; u32x2 w; w.x = cvtpk(v[j][0], v[j][1]); w.y = cvtpk(v[j][2], v[j][3]); o[64 * j] = w; }
    if (lane == 0) rs[row] = rsqrtf(s * (1.f / DM) + EPS);
}

template <int NR, bool XBF, bool WOUT, bool WXB = true>
__device__ __forceinline__ void rows_final(const float* xp, const float* xs, const bf16_t* __restrict__ Y, const float* __restrict__ ss, const float* __restrict__ gpost, float* out, bf16_t* xb, float* rs, int row0, int lane) {
    f32x4 v[NR][4]; u32x2 yy[NR][4]; float ssl[NR];
#pragma unroll
    for (int r = 0; r < NR; ++r) { const int row = row0 + r;
        const float* xrow = (row < NP_TOK) ? xp + (size_t)row * DM : xs + (size_t)(row - NP_TOK) * DM;
        ssl[r] = (lane < 32) ? ss[(size_t)row * 32 + lane] : 0.f;
#pragma unroll
        for (int j = 0; j < 4; ++j) {
            if (XBF) { const u32x2 xw = *((const u32x2*)(xb + (size_t)row * DM) + lane + 64 * j); v[r][j] = (f32x4){bflo(xw.x), bfhi(xw.x), bflo(xw.y), bfhi(xw.y)}; }
            else v[r][j] = *((const f32x4*)xrow + lane + 64 * j);
            yy[r][j] = *((const u32x2*)(Y + (size_t)row * DM) + lane + 64 * j); } }
    f32x4 g[4];
#pragma unroll
    for (int j = 0; j < 4; ++j) g[j] = *((const f32x4*)gpost + lane + 64 * j);
#pragma unroll
    for (int r = 0; r < NR; ++r) { const int row = row0 + r;
        const float rn = rsqrtf(wave_sum(ssl[r]) * (1.f / DM) + EPS); float s = 0.f;
#pragma unroll
        for (int j = 0; j < 4; ++j) { const f32x4 yf = {bflo(yy[r][j].x), bfhi(yy[r][j].x), bflo(yy[r][j].y), bfhi(yy[r][j].y)};
            v[r][j] = v[r][j] + yf * rn * g[j]; s += (v[r][j][0] * v[r][j][0] + v[r][j][1] * v[r][j][1]) + (v[r][j][2] * v[r][j][2] + v[r][j][3] * v[r][j][3]); }
        s = wave_sum(s);
        f32x4* oo = (f32x4*)(out + (size_t)row * DM) + lane; u32x2* o = (u32x2*)(xb + (size_t)row * DM) + lane;
#pragma unroll
        for (int j = 0; j < 4; ++j) { if (WOUT) oo[64 * j] = v[r][j]; if (WXB) { u32x2 w; w.x = cvtpk(v[r][j][0], v[r][j][1]); w.y = cvtpk(v[r][j][2], v[r][j][3]); o[64 * j] = w; } }
        if (WXB && lane == 0) rs[row] = rsqrtf(s * (1.f / DM) + EPS); }
}
template <int NR>
__device__ __forceinline__ void rows_prep(const float* xp, const float* xs, bf16_t* xb, float* rs, int row0, int lane) {
    f32x4 v[NR][4];
#pragma unroll
    for (int r = 0; r < NR; ++r) { const int row = row0 + r;
        const float* xrow = (row < NP_TOK) ? xp + (size_t)row * DM : xs + (size_t)(row - NP_TOK) * DM;
#pragma unroll
        for (int j = 0; j < 4; ++j) v[r][j] = *((const f32x4*)xrow + lane + 64 * j); }
#pragma unroll
    for (int r = 0; r < NR; ++r) { const int row = row0 + r; float s = 0.f;
#pragma unroll
        for (int j = 0; j < 4; ++j) s += (v[r][j][0] * v[r][j][0] + v[r][j][1] * v[r][j][1]) + (v[r][j][2] * v[r][j][2] + v[r][j][3] * v[r][j][3]);
        s = wave_sum(s);
        u32x2* o = (u32x2*)(xb + (size_t)row * DM) + lane;
#pragma unroll
        for (int j = 0; j < 4; ++j) { u32x2 w; w.x = cvtpk(v[r][j][0], v[r][j][1]); w.y = cvtpk(v[r][j][2], v[r][j][3]); o[64 * j] = w; }
        if (lane == 0) rs[row] = rsqrtf(s * (1.f / DM) + EPS); }
}

constexpr int PH_PER_LAYER = 8, N_PHASES = 1 + DEPTH * PH_PER_LAYER;

__global__ void __launch_bounds__(512, 2) mk_fwd(Params p) {
    extern __shared__ __attribute__((aligned(16))) unsigned char lds_raw[];
    LAS unsigned char* lds = (LAS unsigned char*)lds_raw;
    cg::grid_group grid = cg::this_grid();
    const int G = gridDim.x, bid = blockIdx.x;
    volatile LAS unsigned* bst = (volatile LAS unsigned*)(lds + LDS_BYTES - 16);
    if (threadIdx.x < 4) bst[threadIdx.x] = 0u;
    __syncthreads();
    (void)xcd_barrier_post((unsigned*)(p.ws + WS_BAR), bst);
#define XBAR() do { XcdBarrier b_; { unsigned char* w_ = p.ws; asm volatile("" : "+s"(w_)); b_.bar = (unsigned*)(w_ + WS_BAR); } b_.x = xb_xcc_id(); b_.st = (volatile LAS unsigned*)(lds + LDS_BYTES - 16); xcd_barrier(b_); } while (0)
#define TIDS int tid = threadIdx.x; asm volatile("" : "+v"(tid)); const int lane = tid & 63, wave = __builtin_amdgcn_readfirstlane(tid >> 6); const int gw = bid * 8 + wave, NGW = G * 8; (void)lane; (void)gw; (void)NGW;
#define WSPTRS \
    unsigned char* ws = p.ws; asm volatile("" : "+s"(ws)); \
    bf16_t* U = (bf16_t*)(ws + WS_U); bf16_t* OCV = (bf16_t*)(ws + WS_OCV); bf16_t* XB = (bf16_t*)(ws + WS_XB); bf16_t* WB = (bf16_t*)(ws + WS_W); \
    float* RSA = (float*)(ws + WS_RSA); float* RSB = (float*)(ws + WS_RSB); float* SS = (float*)(ws + WS_SS); \
    bf16_t* MERGED = (bf16_t*)(ws + WS_MERGED); bf16_t* Y1 = (bf16_t*)(ws + WS_Y1); u32x4* GSCR = (u32x4*)(ws + WS_GSCR); bf16_t* HID = (bf16_t*)(ws + WS_HID); bf16_t* Y2 = (bf16_t*)(ws + WS_Y2); \
    const bf16_t* wl = WB + (size_t)l * W_LAYER; (void)U; (void)OCV; (void)XB; (void)RSA; (void)RSB; (void)SS; (void)MERGED; (void)Y1; (void)GSCR; (void)HID; (void)Y2; (void)wl;
#if MK_SPLIT
    const int lo = p.ph_lo, hi = p.ph_hi;
#define IN(k) (lo <= (k) && (k) < hi)
#define SEAM(k) do { if (IN(k) && IN((k) + 1)) grid.sync(); } while (0)
#else
#define IN(k) true
#define SEAM(k) do { if ((k) == 0) grid.sync(); else XBAR(); } while (0)
#endif

    if (IN(0)) {
        const int l = 0; WSPTRS (void)l; TIDS
        LAS float* scr = (LAS float*)(lds + wave * 16384);
        constexpr int I_MIX = 16 * (MIXC / 32), I_GATE = 16 * (GATEC / 32), I_BR = 8 * (DM / 32), I_OUT = 16 * (DM / 32), I_F1 = 16 * (FF2 / 32), I_F2 = (FFH / 64) * (DM / 32);
        constexpr int I_LAYER = I_MIX + I_GATE + 3 * I_BR + I_OUT + I_F1 + I_F2;
        for (int it = gw; it < DEPTH * I_LAYER; it += NGW) {
            const int l2 = it / I_LAYER; int r = it % I_LAYER; bf16_t* wl2 = WB + (size_t)l2 * W_LAYER;
            const float* win = p.in[I_WIN] + (size_t)l2 * DM * IN_COLS;
            if (r < I_MIX) { wprep_item(win, IN_COLS, DM, wl2 + W_MIX, MIXC / 32, r, 2, 0, p.in[I_LMPRE] + l2 * DM, scr, lane); continue; } r -= I_MIX;
            if (r < I_GATE) { wprep_item(win, IN_COLS, DM, wl2 + W_GATE, GATEC / 32, r, 0, MIXC, p.in[I_LMPRE] + l2 * DM, scr, lane); continue; } r -= I_GATE;
            if (r < 3 * I_BR) { const int b = r / I_BR; wprep_item(p.in[I_WBR] + (size_t)(l2 * 3 + b) * 512 * DM, DM, 512, wl2 + W_BR + (size_t)b * DM * 512, DM / 32, r % I_BR, 0, 0, nullptr, scr, lane); continue; } r -= 3 * I_BR;
            if (r < I_OUT) { wprep_item(p.in[I_WOUT] + (size_t)l2 * DM * DM, DM, DM, wl2 + W_OUT, DM / 32, r, 0, 0, nullptr, scr, lane); continue; } r -= I_OUT;
            if (r < I_F1) { wprep_item(p.in[I_WF1] + (size_t)l2 * DM * FF2, FF2, DM, wl2 + W_F1, FF2 / 32, r, 1, 0, p.in[I_LFPRE] + l2 * DM, scr, lane); continue; } r -= I_F1;
            wprep_item(p.in[I_WF2] + (size_t)l2 * FFH * DM, DM, FFH, wl2 + W_F2, DM / 32, r, 0, 0, nullptr, scr, lane);
        }
        for (int m = gw * 4; m < T_TOK; m += NGW * 4) rows_prep<4>(p.in[I_XP], p.in[I_XS], XB, RSA, m, lane);
    }
    SEAM(0);

    for (int l = 0; l < DEPTH; ++l) {
        const int pb = 1 + l * PH_PER_LAYER;
        const float lam_init = 0.8f - 0.6f * expf(-0.3f * (float)l);
        if (IN(pb + 0)) { WSPTRS
#ifndef NO_G1
            PREP {
            pg8::Gemm g{XB, wl + W_MIX, T_TOK, MIXC, DM}; pg8::StaticOrder S; S.init(T_TOK, MIXC, G, bid);
            pg8::EpiMix E{U, RSA};
            pg8::gemm_phase<pg8::EpiMix, pg8::StaticOrder, true, true>(lds, g, S, E);
            }
#endif
        }
        SEAM(pb + 0);
        if (IN(pb + 1)) { WSPTRS TIDS
            LAS float* tabf = (LAS float*)(lds + LDS_TAB);
            for (int i = tid; i < 4 * 257; i += 512) { const int hd = i / 257, j = i % 257; tabf[i] = p.in[I_T5][t5_bucket(j - 128) * 4 + hd] * LOG2E; }
            if (wave == 0) { const float* lm = p.in[I_LAM] + l * 256;
                const float a = wave_sum(lm[lane] * lm[64 + lane]), b = wave_sum(lm[128 + lane] * lm[192 + lane]);
                if (lane == 0) tabf[4 * 257] = expf(a) - expf(b) + lam_init; }
            __syncthreads();
            const float lam = tabf[4 * 257];
            const float* subg = p.in[I_SUBG] + l * 128;
            bf16_t* DQ = U + S_DQ * SEC_ELEMS; const bf16_t* DK = U + S_DK * SEC_ELEMS; const bf16_t* DV = U + S_DV * SEC_ELEMS;
#ifndef NO_DIFF
#ifdef PROBE_DIFF
            for (int rep = 0; rep < 2; ++rep)
#else
            const int rep = 1;
#endif
            for (int uu = bid; uu < 2560; uu += G) {
                const int rnd = uu >> 8, idx = uu & 255, xcd = idx & 7, slot = idx >> 3; long R0; int S, hd, qb;
                if (rnd < 8) { const int pair = rnd * 16 + xcd * 2 + (slot >> 4); R0 = (long)(pair >> 2) * SEQ_P; S = SEQ_P; hd = pair & 3; qb = slot & 15; }
                else { const int pair = (rnd - 8) * 4 + (xcd >> 1); R0 = (long)NP_TOK + (long)(pair >> 2) * SEQ_S; S = SEQ_S; hd = pair & 3; qb = (xcd & 1) * 32 + slot; }
                diff_unit(lds, DK, DV, DQ, R0, S, hd, qb, lam, 1.f - lam_init, subg, rep == 0);
            }
#endif
#ifndef NO_NA
            __syncthreads();
            for (int i = tid; i < 8 * 465; i += 512) tabf[i] = p.in[I_RPB][l * 3720 + i] * LOG2E;
            __syncthreads();
            bf16_t* NAQ = U + S_NAQ * SEC_ELEMS; const bf16_t* NAK = U + S_NAK * SEC_ELEMS; const bf16_t* NAV = U + S_NAV * SEC_ELEMS;
#ifdef PROBE_NA
            for (int rep2 = 0; rep2 < 2; ++rep2)
#else
            const int rep2 = 1;
#endif
            for (int uraw = bid; uraw < 4 * (T_TOK / 128); uraw += G) {
                const int uidx = (uraw & ~255) + (uraw & 7) * 32 + ((uraw >> 3) & 31); const int hpair = uidx & 3, gp = uidx >> 2;
                long R0; int rows, r0;
                if (gp < NP_TOK / 128) { const int b = gp / (SEQ_P / 128); r0 = 2 * (gp % (SEQ_P / 128)); rows = SEQ_P / 64; R0 = (long)b * SEQ_P; }
                else { const int g2 = gp - NP_TOK / 128; const int b = g2 / (SEQ_S / 128); r0 = 2 * (g2 % (SEQ_S / 128)); rows = SEQ_S / 64; R0 = (long)NP_TOK + (long)b * SEQ_S; }
                na_unit(lds, NAK, NAV, NAQ, R0, rows, r0, hpair, rep2 == 0); }
#endif
#ifndef NO_CONV
            const bf16_t* CA = U + S_CA * SEC_ELEMS; const bf16_t* CGp = U + S_CG * SEC_ELEMS;
#define CONV_DECODE(u_, R0_, S_, t0_) do { const int tg_ = (u_) * 32; if (tg_ < NP_TOK) { R0_ = (long)(tg_ / SEQ_P) * SEQ_P; S_ = SEQ_P; t0_ = tg_ % SEQ_P; } \
                else { const int t2_ = tg_ - NP_TOK; R0_ = (long)NP_TOK + (long)(t2_ / SEQ_S) * SEQ_S; S_ = SEQ_S; t0_ = t2_ % SEQ_S; } } while (0)
            int ctid = threadIdx.x; asm volatile("" : "+v"(ctid));
            f32x2 cw[31]; f32x4 clnp[4];
            { const float* dww = p.in[I_DWW] + l * 31 * 512; const int cp = ctid & 255, cl = ctid & 63;
#pragma unroll
              for (int k = 0; k < 31; ++k) cw[k] = *(const f32x2*)(dww + k * 512 + 2 * cp);
              clnp[0] = *(const f32x4*)(p.in[I_CLG] + l * 512 + 8 * cl); clnp[1] = *(const f32x4*)(p.in[I_CLG] + l * 512 + 8 * cl + 4);
              clnp[2] = *(const f32x4*)(p.in[I_CLB] + l * 512 + 8 * cl); clnp[3] = *(const f32x4*)(p.in[I_CLB] + l * 512 + 8 * cl + 4); }
            const f32x2 cbv = *(const f32x2*)(p.in[I_DWB] + l * 512 + 2 * (ctid & 255));
            { long cR0 = 0, nR0 = 0; int cS = 0, ct0 = 0, nS = 0, nt0 = 0; bool pre = false; int uidx = bid;
              if (uidx < T_TOK / 32) CONV_DECODE(uidx, cR0, cS, ct0);
              while (uidx < T_TOK / 32) { const int nu = uidx + G; const bool hn = nu < T_TOK / 32; if (hn) CONV_DECODE(nu, nR0, nS, nt0);
                  conv_unit(lds, CA, CGp, OCV, cw, cbv, clnp, ctid, cR0, cS, ct0, pre, hn, nR0, nS, nt0);
                  pre = hn; cR0 = nR0; cS = nS; ct0 = nt0; uidx = nu; } }
#undef CONV_DECODE
#endif
        }
        SEAM(pb + 1);
        if (IN(pb + 2)) { WSPTRS
#ifndef NO_G3
            PREP {
            u32x4* G01 = (u32x4*)p.out;
            { pg8::Gemm g{XB, wl + W_GATE, T_TOK, GATEC, DM}; pg8::StaticOrder S3; S3.init(T_TOK, GATEC, G, bid);
              pg8::EpiGate E{G01, GSCR, RSA, p.in[I_BGATE] + l * GATEC};
              pg8::gemm_phase<pg8::EpiGate, pg8::StaticOrder, true, true>(lds, g, S3, E); }
            { pg8::Grouped3Order S; S.so.init(T_TOK, DM, G, bid); S.a1 = (size_t)(WS_OCV - WS_U); S.a2 = (size_t)S_DQ * SEC_BYTES; S.bstep = (size_t)DM * 512 * 2;
              pg8::Gemm g{U, wl + W_BR, T_TOK, DM, 512}; pg8::EpiProj E{G01, GSCR, MERGED};
              pg8::gemm_phase<pg8::EpiProj, pg8::Grouped3Order, true, true>(lds, g, S, E); }
            }
#endif
        }
        SEAM(pb + 2);
        if (IN(pb + 3)) { WSPTRS
#ifndef NO_G4
            PREP {
            pg8::Gemm g{MERGED, wl + W_OUT, T_TOK, DM, DM}; pg8::StaticOrder S; S.init(T_TOK, DM, G, bid);
            pg8::EpiY E{Y1, SS + (size_t)(2 * l) * T_TOK * 32};
            pg8::gemm_phase<pg8::EpiY, pg8::StaticOrder, true, true>(lds, g, S, E);
            }
#endif
        }
        SEAM(pb + 3);
        if (IN(pb + 4)) { WSPTRS TIDS
            if (l == 0) { for (int m = gw * 4; m < T_TOK; m += NGW * 4) rows_final<4, false, false>(p.in[I_XP], p.in[I_XS], Y1, SS + (size_t)(2 * l) * T_TOK * 32, p.in[I_LMPOST] + l * DM, p.out, XB, RSB, m, lane); }
            else { for (int m = gw * 4; m < T_TOK; m += NGW * 4) rows_final<4, true, false>(nullptr, nullptr, Y1, SS + (size_t)(2 * l) * T_TOK * 32, p.in[I_LMPOST] + l * DM, p.out, XB, RSB, m, lane); }
        }
        SEAM(pb + 4);
        if (IN(pb + 5)) { WSPTRS
#ifndef NO_G6
            PREP {
            pg8::Gemm g{XB, wl + W_F1, T_TOK, FF2, DM}; pg8::StaticOrder S; S.init(T_TOK, FF2, G, bid);
            pg8::EpiFfn E{HID, RSB};
            pg8::gemm_phase<pg8::EpiFfn, pg8::StaticOrder, true, true>(lds, g, S, E);
            }
#endif
        }
        SEAM(pb + 5);
        if (IN(pb + 6)) { WSPTRS
#ifndef NO_G7
            PREP {
            pg8::Gemm g{HID, wl + W_F2, T_TOK, DM, FFH}; pg8::StaticOrder S; S.init(T_TOK, DM, G, bid);
            pg8::EpiY E{Y2, SS + (size_t)(2 * l + 1) * T_TOK * 32};
            pg8::gemm_phase<pg8::EpiY, pg8::StaticOrder, true, true>(lds, g, S, E);
            }
#endif
        }
        SEAM(pb + 6);
        if (IN(pb + 7)) { WSPTRS TIDS
            if (l + 1 < DEPTH) { for (int m = gw * 4; m < T_TOK; m += NGW * 4) rows_final<4, true, false>(nullptr, nullptr, Y2, SS + (size_t)(2 * l + 1) * T_TOK * 32, p.in[I_LFPOST] + l * DM, p.out, XB, RSA, m, lane); }
            else { for (int m = gw * 4; m < T_TOK; m += NGW * 4) rows_final<4, true, true, false>(nullptr, nullptr, Y2, SS + (size_t)(2 * l + 1) * T_TOK * 32, p.in[I_LFPOST] + l * DM, p.out, XB, RSA, m, lane); }
        }
        if (l + 1 < DEPTH) { SEAM(pb + 7); }
    }
#undef IN
#undef SEAM
}

extern "C" void kernel_launch(void* const* d_in, const int* in_sizes, int n_in, void* d_out, int out_size, void* d_ws, size_t ws_size, hipStream_t stream) {
    static int grid = 0;
    if (grid == 0) {
        if (n_in != 20 || ws_size < WS_END) { fprintf(stderr, "kernel_launch: unexpected n_in %d / ws_size %zu (need %zu)\n", n_in, ws_size, (size_t)WS_END); grid = -1; return; }
        int dev = 0, cus = 0, per_cu = 0;
        hipGetDevice(&dev);
        hipDeviceGetAttribute(&cus, hipDeviceAttributeMultiprocessorCount, dev);
        if (hipFuncSetAttribute((const void*)mk_fwd, hipFuncAttributeMaxDynamicSharedMemorySize, LDS_BYTES) != hipSuccess) { fprintf(stderr, "kernel_launch: hipFuncSetAttribute failed\n"); grid = -1; return; }
        if (hipOccupancyMaxActiveBlocksPerMultiprocessor(&per_cu, (const void*)mk_fwd, 512, LDS_BYTES) != hipSuccess || per_cu < 1) { fprintf(stderr, "kernel_launch: occupancy query gave %d\n", per_cu); per_cu = 1; }
        (void)hipGetLastError();
        grid = cus * per_cu;
        if (grid > 256) grid = 256;
    }
    if (grid < 0) return;
    Params p{};
    for (int i = 0; i < 20; ++i) p.in[i] = (const float*)d_in[i];
    p.out = (float*)d_out; p.ws = (unsigned char*)d_ws;
#if MK_SPLIT
    for (int ph = 0; ph < N_PHASES; ++ph) {
        p.ph_lo = ph; p.ph_hi = ph + 1;
        hipLaunchKernelGGL(mk_fwd, dim3(grid), dim3(512), LDS_BYTES, stream, p);
    }
#else
    p.ph_lo = 0; p.ph_hi = N_PHASES;
    (void)hipMemsetAsync((char*)d_ws + WS_BAR, 0, BAR_BYTES, stream);
    void* args[] = {&p};
    hipError_t e = hipLaunchCooperativeKernel((const void*)mk_fwd, dim3(grid), dim3(512), args, LDS_BYTES, stream);
    if (e != hipSuccess) fprintf(stderr, "cooperative launch failed: %s (grid %d)\n", hipGetErrorString(e), grid);
#endif
}
```
